# Optimizing an MI355X kernel written in HIP

```python
import jax, jax.numpy as jnp
from jax import lax
import numpy as np

D_MODEL = 2048
BATCH = 4
SEQ = 4096
DEPTH = 1

CTX_LEN = 256
GRID_W = 64

MIX_A = 1024
MIX_B = 1024
SGU_GROUPS = 4
SGU_CHUNK = 128
SGU_GW = MIX_A // SGU_GROUPS
GLA_HEADS = 4
GLA_DK = MIX_B // 2 // GLA_HEADS
GLA_DV = MIX_B // GLA_HEADS
GLA_KDIM = GLA_HEADS * GLA_DK
GLA_LOWRANK = 16
GLA_NORMALIZER = 16.0
GLA_CHUNK = 64
D_FF = 5632
CONV_W = 3
EPS = 1e-6
N_IN = 2 * MIX_A + 2 * GLA_KDIM + 2 * MIX_B + 2 * GLA_LOWRANK
N_MOD = 6

kernel_name = "hybrid_sgu_gla_convglu_prefix_dit_layer"


def rmsnorm(x, g):
    xf = x.astype(jnp.float32)
    y = xf * lax.rsqrt(jnp.mean(xf * xf, axis=-1, keepdims=True) + EPS)
    return (y * g.astype(jnp.float32)).astype(x.dtype)


def layernorm(x, g, b):
    xf = x.astype(jnp.float32)
    mu = jnp.mean(xf, axis=-1, keepdims=True)
    var = jnp.mean(jnp.square(xf - mu), axis=-1, keepdims=True)
    y = (xf - mu) * lax.rsqrt(var + EPS)
    return (y * g.astype(jnp.float32) + b.astype(jnp.float32)).astype(x.dtype)


def flip_t(t):
    return jnp.flip(t, axis=1)


def spatial_gating(u, v, ln_g, ln_b, w_s, b_s):
    B, L, _ = v.shape
    n = L // SGU_CHUNK
    v = v.reshape(B, n, SGU_CHUNK, SGU_GROUPS, SGU_GW)
    v = layernorm(v, ln_g.reshape(SGU_GROUPS, SGU_GW), ln_b.reshape(SGU_GROUPS, SGU_GW))
    s = jnp.einsum('gpq,bnqgc->bnpgc', w_s, v) + b_s.T[:, :, None]
    return u * s.reshape(B, L, MIX_A)


def gla_log_decay(lr, w, b):
    B, L, _ = lr.shape
    z = (lr @ w + b).astype(jnp.float32)
    return (jax.nn.log_sigmoid(z) / GLA_NORMALIZER).reshape(B, L, GLA_HEADS, GLA_DK)


def gla_chunked(q, k, v, g, s0):
    B, L, H, DK = q.shape
    n = L // GLA_CHUNK
    f = lambda t: t.astype(jnp.float32).reshape(B, n, GLA_CHUNK, H, t.shape[-1])
    q, k, v, g = f(q), f(k), f(v), f(g)
    b = jnp.cumsum(g, axis=2)
    b_last = b[:, :, -1:]
    q_e = q * jnp.exp(b)
    k_e = k * jnp.exp(-b)
    k_d = k * jnp.exp(b_last - b)
    mask = jnp.tril(jnp.ones((GLA_CHUNK, GLA_CHUNK), dtype=bool))
    att = jnp.where(mask, jnp.einsum('bnthd,bnshd->bnhts', q_e, k_e), 0.0)
    o_intra = jnp.einsum('bnhts,bnshv->bnthv', att, v)

    def step(S, inp):
        qe_c, kd_c, v_c, dec_c = inp
        o_c = jnp.einsum('bthd,bhdv->bthv', qe_c, S)
        S = dec_c[..., None] * S + jnp.einsum('bthd,bthv->bhdv', kd_c, v_c)
        return S, o_c

    xs = (jnp.moveaxis(q_e, 1, 0), jnp.moveaxis(k_d, 1, 0), jnp.moveaxis(v, 1, 0),
          jnp.moveaxis(jnp.exp(b_last[:, :, 0]), 1, 0))
    s_fin, o_inter = lax.scan(step, s0.astype(jnp.float32), xs)
    o = o_intra + jnp.moveaxis(o_inter, 0, 1)
    return o.reshape(B, L, H, v.shape[-1]), s_fin


def mix_stream(a, s0_f, s0_b, w_in, sgu_ln_g, sgu_ln_b, sgu_w, sgu_b,
               gla_gate_w_f, gla_gate_b_f, gla_gate_w_b, gla_gate_b_b, gla_norm_g, w_out, with_output):
    B, L, _ = a.shape
    p = a @ w_in
    cuts = np.cumsum([MIX_A, MIX_A, GLA_KDIM, GLA_KDIM, MIX_B, MIX_B, GLA_LOWRANK]).tolist()
    u, v_s, q, k, v, r, lr_f, lr_b = jnp.split(p, cuts, axis=-1)
    q = q.reshape(B, L, GLA_HEADS, GLA_DK) * (GLA_DK ** -0.5)
    k = k.reshape(B, L, GLA_HEADS, GLA_DK)
    v = v.reshape(B, L, GLA_HEADS, GLA_DV)
    g_f = gla_log_decay(lr_f, gla_gate_w_f, gla_gate_b_f)
    g_b = gla_log_decay(lr_b, gla_gate_w_b, gla_gate_b_b)
    o_f, s_f = gla_chunked(q, k, v, g_f, s0_f)
    o_b_rev, s_b = gla_chunked(flip_t(q), flip_t(k), flip_t(v), flip_t(g_b), s0_b)
    if not with_output:
        return None, s_f, s_b
    o = o_f + flip_t(o_b_rev)
    o = o * lax.rsqrt(jnp.mean(o * o, axis=-1, keepdims=True) + EPS) * gla_norm_g.astype(jnp.float32)
    o = o * jax.nn.silu(r.astype(jnp.float32)).reshape(B, L, GLA_HEADS, GLA_DV)
    y_b = o.reshape(B, L, MIX_B).astype(a.dtype)
    y_a = spatial_gating(jax.nn.gelu(u, approximate=True), jax.nn.gelu(v_s, approximate=True),
                         sgu_ln_g, sgu_ln_b, sgu_w, sgu_b)
    y = jnp.concatenate([y_a, y_b], axis=-1) @ w_out
    return y, s_f, s_b


def conv_glu_ffn(h, w_up, conv_w, conv_b, w_down, rows):
    B, L, _ = h.shape
    a, val = jnp.split(h @ w_up, 2, axis=-1)
    a = a.reshape(B, rows, L // rows, D_FF)
    a = lax.conv_general_dilated(a, conv_w[:, :, None, :].astype(a.dtype), (1, 1), 'SAME',
                                 dimension_numbers=('NHWC', 'HWIO', 'NHWC'),
                                 feature_group_count=D_FF) + conv_b
    a = a.reshape(B, L, D_FF)
    return (jax.nn.gelu(a, approximate=True) * val) @ w_down


def setup_inputs(seed: int = 0) -> dict:
    key = jax.random.key(seed)
    ks = jax.random.split(key, 32)
    nrm = lambda k, shape, s: jax.random.normal(k, shape, jnp.float32) * s
    gain = lambda k, shape: 1.0 + 0.05 * jax.random.normal(k, shape, jnp.float32)
    D = D_MODEL
    return {
        "x": nrm(ks[0], (BATCH, SEQ, D), 1.0),
        "c": nrm(ks[1], (BATCH, D), 1.0),
        "ctx": nrm(ks[2], (BATCH, CTX_LEN, D), 1.0),
        "c_ctx": nrm(ks[3], (D,), 1.0),
        "ada_w": nrm(ks[4], (DEPTH, D, N_MOD * D), D ** -0.5),
        "ada_b": nrm(ks[5], (DEPTH, N_MOD * D), 0.02),
        "pre_mix_g": gain(ks[6], (DEPTH, D)),
        "post_mix_g": gain(ks[7], (DEPTH, D)),
        "pre_ffn_g": gain(ks[8], (DEPTH, D)),
        "post_ffn_g": gain(ks[9], (DEPTH, D)),
        "w_in": nrm(ks[10], (DEPTH, D, N_IN), D ** -0.5),
        "sgu_ln_g": gain(ks[11], (DEPTH, MIX_A)),
        "sgu_ln_b": nrm(ks[12], (DEPTH, MIX_A), 0.02),
        "sgu_w": nrm(ks[13], (DEPTH, SGU_GROUPS, SGU_CHUNK, SGU_CHUNK), SGU_CHUNK ** -0.5),
        "sgu_b": gain(ks[14], (DEPTH, SGU_GROUPS, SGU_CHUNK)),
        "gla_gate_w_f": nrm(ks[15], (DEPTH, GLA_LOWRANK, GLA_KDIM), GLA_LOWRANK ** -0.5),
        "gla_gate_b_f": nrm(ks[16], (DEPTH, GLA_KDIM), 0.1),
        "gla_gate_w_b": nrm(ks[17], (DEPTH, GLA_LOWRANK, GLA_KDIM), GLA_LOWRANK ** -0.5),
        "gla_gate_b_b": nrm(ks[18], (DEPTH, GLA_KDIM), 0.1),
        "gla_norm_g": gain(ks[19], (DEPTH, GLA_DV)),
        "w_out": nrm(ks[20], (DEPTH, MIX_A + MIX_B, D), (MIX_A + MIX_B) ** -0.5),
        "ffn_w_up": nrm(ks[21], (DEPTH, D, 2 * D_FF), D ** -0.5),
        "ffn_conv_w": nrm(ks[22], (DEPTH, CONV_W, CONV_W, D_FF), 1.0 / CONV_W),
        "ffn_conv_b": nrm(ks[23], (DEPTH, D_FF), 0.02),
        "ffn_w_down": nrm(ks[24], (DEPTH, D_FF, D), D_FF ** -0.5),
    }


def reference(x, c, ctx, c_ctx, ada_w, ada_b, pre_mix_g, post_mix_g, pre_ffn_g, post_ffn_g,
              w_in, sgu_ln_g, sgu_ln_b, sgu_w, sgu_b, gla_gate_w_f, gla_gate_b_f,
              gla_gate_w_b, gla_gate_b_b, gla_norm_g, w_out, ffn_w_up, ffn_conv_w, ffn_conv_b, ffn_w_down):
    B, L, _ = x.shape
    rows = L // GRID_W
    s_zero = jnp.zeros((B, GLA_HEADS, GLA_DK, GLA_DV), jnp.float32)
    h, hc = x, ctx
    for i in range(DEPTH):
        ctx_out = i < DEPTH - 1
        mod = jax.nn.silu(c) @ ada_w[i] + ada_b[i]
        sh_m, sc_m, gt_m, sh_f, sc_f, gt_f = jnp.split(mod[:, None, :], N_MOD, axis=-1)
        mod_c = jax.nn.silu(c_ctx) @ ada_w[i] + ada_b[i]
        csh_m, csc_m, cgt_m, csh_f, csc_f, cgt_f = jnp.split(mod_c, N_MOD, axis=-1)
        mix_w = (w_in[i], sgu_ln_g[i], sgu_ln_b[i], sgu_w[i], sgu_b[i], gla_gate_w_f[i], gla_gate_b_f[i],
                 gla_gate_w_b[i], gla_gate_b_b[i], gla_norm_g[i], w_out[i])
        a_ctx = rmsnorm(hc, pre_mix_g[i]) * (1.0 + csc_m) + csh_m
        y_ctx, s_f, s_b = mix_stream(a_ctx, s_zero, s_zero, *mix_w, ctx_out)
        a_lat = rmsnorm(h, pre_mix_g[i]) * (1.0 + sc_m) + sh_m
        y_lat, _, _ = mix_stream(a_lat, s_f, s_b, *mix_w, True)
        h = h + gt_m * rmsnorm(y_lat, post_mix_g[i])
        f = rmsnorm(h, pre_ffn_g[i]) * (1.0 + sc_f) + sh_f
        h = h + gt_f * rmsnorm(conv_glu_ffn(f, ffn_w_up[i], ffn_conv_w[i], ffn_conv_b[i], ffn_w_down[i], rows),
                               post_ffn_g[i])
        if ctx_out:
            hc = hc + cgt_m * rmsnorm(y_ctx, post_mix_g[i])
            fc = rmsnorm(hc, pre_ffn_g[i]) * (1.0 + csc_f) + csh_f
            hc = hc + cgt_f * rmsnorm(conv_glu_ffn(fc, ffn_w_up[i], ffn_conv_w[i], ffn_conv_b[i], ffn_w_down[i], 1),
                                      post_ffn_g[i])
    return h
```

```cpp
#include <hip/hip_runtime.h>
#include <hip/hip_cooperative_groups.h>
#include <cstdio>
#include <cstdint>
namespace cg = cooperative_groups;
namespace pg8 {
#define PG8_LAS __attribute__((address_space(3)))
typedef unsigned short bf16_t;
typedef short bf16x8 __attribute__((ext_vector_type(8)));
typedef float f32x4 __attribute__((ext_vector_type(4)));
typedef unsigned u32x4 __attribute__((ext_vector_type(4)));
constexpr int BM = 256, BK = 64, HALF = 128, HTB = HALF * BK * 2  , STAGE_BYTES = 8 * HTB, NXCD = 8, WGM = 8;

__host__ __device__ __forceinline__ int lds_byte(int r, int c) { const int st = (r >> 4) * 2 + (c >> 5), rr = r & 15, cc = c & 31, ob = rr * 64 + cc * 2; return st * 1024 + (ob ^ (((ob >> 9) & 1) << 5)); }
__host__ __device__ __forceinline__ void stage_rc(int b, int& R, int& C) { const int st = b / 1024, sb = b % 1024, swz = sb ^ (((sb >> 9) & 1) << 5); R = (st >> 1) * 16 + swz / 64; C = (st & 1) * 32 + (swz % 64) / 2; }
__host__ __device__ __forceinline__ int perm32(int rho) { const int n = rho >> 4, i = rho & 15; return 8 * (i >> 2) + 4 * n + (i & 3); }

struct Unit { int pm, pn; };
struct Gemm { const bf16_t* A; const bf16_t* Bt; int M, N, K, lda; };

struct StaticOrder {
    int nM, nN, nwg, G, c;
    __host__ __device__ void init(int M, int N, int G_, int c_) { nM = M / BM; nN = N / BM; nwg = nM * nN; G = G_; c = c_; }
    __host__ __device__ bool next(int i, Unit& u) const {
        const long L = (long)i * G + c; if (L >= nwg) return false;
        int wgid = (int)L; { const int q = nwg / NXCD, r = nwg % NXCD, xcd = wgid % NXCD, off = wgid / NXCD; wgid = (xcd < r ? xcd * (q + 1) : r * (q + 1) + (xcd - r) * q) + off; }
        const int nig = WGM * nN, gid = wgid / nig, fm = gid * WGM, gsz = (nM - fm) < WGM ? (nM - fm) : WGM;
        u.pm = fm + ((wgid % nig) % gsz); u.pn = (wgid % nig) / gsz; return true;
    }
    __device__ __forceinline__ void a_ready(const Unit&) const {}
    __device__ __forceinline__ void done(const Unit&) const {}
};

__device__ __forceinline__ unsigned cvt_pk_bf16(float lo, float hi) { unsigned r; asm volatile("v_cvt_pk_bf16_f32 %0, %1, %2" : "=v"(r) : "v"(lo), "v"(hi)); return r; }
typedef float f32x2 __attribute__((ext_vector_type(2)));
__device__ __forceinline__ f32x2 gelu_pk(f32x2 v) {
    const f32x2 av = __builtin_elementwise_abs(v), d = av * 0.2316418882f + 1.0f;
    f32x2 t; t.x = __builtin_amdgcn_rcpf(d.x); t.y = __builtin_amdgcn_rcpf(d.y);
    f32x2 q = t * 0.5307027145f + (-0.7265760135f); q = q * t + 0.7107068705f; q = q * t + (-0.142248368f); q = q * t + 0.127414796f; q = q * t;
    const f32x2 s = (v * v) * (-0.72134752044f);
    f32x2 e; e.x = __builtin_amdgcn_exp2f(s.x); e.y = __builtin_amdgcn_exp2f(s.y);
    const f32x2 m = v * (q * e), r = v - m;
    f32x2 o; o.x = v.x < 0.f ? m.x : r.x; o.y = v.y < 0.f ? m.y : r.y; return o;
}

template <int ACT  > struct EpiBf16 {
    static constexpr bool PERM = true, AFTER_DRAIN = false; static_assert(ACT == 0 || ACT == 1, "EpiBf16: ACT is 0 (none) or 1 (gelu_pk)");
    bf16_t* O; int ldc; const float* bias; int split_cols; size_t split_stride; float scale0;
    __device__ __forceinline__ void operator()(const f32x4 (&acc)[2][2][4][2], const Unit& u, int wr, int wc, int fr, int fq) const {
        const int row0 = u.pm * BM + wr * 64 + fr; int colt = u.pn * BM; bf16_t* base = O;
        float sc = 1.f; if (split_cols) { const int t = colt / split_cols; base += (size_t)t * split_stride; colt -= t * split_cols; if (t == 0) sc = scale0; }
        const int col0 = colt + wc * 32 + 8 * fq, bcol0 = u.pn * BM + wc * 32 + 8 * fq;
        f32x4 bv[2][2];
#pragma unroll
        for (int bj = 0; bj < 2; ++bj)
#pragma unroll
            for (int n = 0; n < 2; ++n) bv[bj][n] = bias ? *(const f32x4*)(bias + bcol0 + bj * HALF + 4 * n) : (f32x4){0.f, 0.f, 0.f, 0.f};
#pragma unroll
        for (int ai = 0; ai < 2; ++ai)
#pragma unroll
            for (int m = 0; m < 4; ++m) { bf16_t* rowp = base + (size_t)(row0 + ai * HALF + m * 16) * ldc + col0;
#pragma unroll
                for (int bj = 0; bj < 2; ++bj) { f32x4 v0 = acc[ai][bj][m][0] + bv[bj][0], v1 = acc[ai][bj][m][1] + bv[bj][1];
                    if (ACT == 1) { f32x2 a = gelu_pk((f32x2){v0[0], v0[1]}), b = gelu_pk((f32x2){v0[2], v0[3]}), c = gelu_pk((f32x2){v1[0], v1[1]}), d = gelu_pk((f32x2){v1[2], v1[3]});
                        v0 = (f32x4){a.x, a.y, b.x, b.y}; v1 = (f32x4){c.x, c.y, d.x, d.y}; }
                    v0 = v0 * sc; v1 = v1 * sc; u32x4 w; w.x = cvt_pk_bf16(v0[0], v0[1]); w.y = cvt_pk_bf16(v0[2], v0[3]); w.z = cvt_pk_bf16(v1[0], v1[1]); w.w = cvt_pk_bf16(v1[2], v1[3]);
                    *(u32x4*)(rowp + bj * HALF) = w; } }
    }
};
template <class Epi, class Sched, bool ALIGN_EPI = false, bool SP2 = false>
__device__ __forceinline__ void gemm_phase(PG8_LAS unsigned char* lds, const Gemm g, const Sched& S, const Epi& E) {
    const int tid = threadIdx.x, wid = __builtin_amdgcn_readfirstlane(tid >> 6), lane = tid & 63, wr = wid >> 2, wc = wid & 3, fr = lane & 15, fq = lane >> 4;
    const int K = g.K, nt = K / BK, LDA = g.lda;
    unsigned voffA[2], voffB[2];
#pragma unroll
    for (int i = 0; i < 2; ++i) { int R, C; stage_rc(tid * 16 + i * 8192, R, C); const int Rb = Epi::PERM ? ((R & ~31) + perm32(R & 31)) : R;
        voffA[i] = (unsigned)(R * LDA + C) * 2u; voffB[i] = (unsigned)(Rb * K + C) * 2u; }
    const size_t kstep = (size_t)(BK * 2);
    const size_t hstepB = (size_t)HALF * K * 2, hstepA = (size_t)HALF * LDA * 2;
    const size_t tstepB = 2 * hstepB, tstepA = 2 * hstepA;
    const unsigned ldsw = (unsigned)wid * 1024u;
    const int aoff = lds_byte(wr * 64 + fr, fq * 8), boff = lds_byte(wc * 32 + fr, fq * 8);
#define PG8_SA(b, h) (((b) * 2 + (h)) * HTB)
#define PG8_SB(b, h) ((4 + (b) * 2 + (h)) * HTB)
#define PG8_STAGE(bufoff, gbase, voff) do { _Pragma("unroll") for (int _i = 0; _i < 2; ++_i) \
        __builtin_amdgcn_global_load_lds((const unsigned*)((const char*)(gbase) + (voff)[_i]), (PG8_LAS unsigned*)(lds + (bufoff) + ldsw + _i * 8192), 16, 0, 0); } while (0)
#define PG8_LDA(dst, b, h) do { _Pragma("unroll") for (int m = 0; m < 4; ++m) _Pragma("unroll") for (int k = 0; k < 2; ++k) dst[m][k] = *(const PG8_LAS bf16x8*)(lds + PG8_SA(b, h) + aoff + m * 2048 + k * 1024); } while (0)
#define PG8_LDB(dst, b, h) do { _Pragma("unroll") for (int n = 0; n < 2; ++n) _Pragma("unroll") for (int k = 0; k < 2; ++k) dst[n][k] = *(const PG8_LAS bf16x8*)(lds + PG8_SB(b, h) + boff + n * 2048 + k * 1024); } while (0)
#define PG8_MMA(ai, bj, At, Bt) do { __builtin_amdgcn_s_setprio(1); _Pragma("unroll") for (int m = 0; m < 4; ++m) _Pragma("unroll") for (int n = 0; n < 2; ++n) _Pragma("unroll") for (int k = 0; k < 2; ++k) \
        acc[ai][bj][m][n] = __builtin_amdgcn_mfma_f32_16x16x32_bf16(Bt[n][k], At[m][k], acc[ai][bj][m][n], 0, 0, 0); __builtin_amdgcn_s_setprio(0); } while (0)
#define PG8_WAIT_V(n) asm volatile("s_waitcnt vmcnt(" #n ")" ::: "memory")
#define PG8_WAIT_L(n) asm volatile("s_waitcnt lgkmcnt(" #n ")" ::: "memory")
#define PG8_BAR __builtin_amdgcn_s_barrier()
#define PG8_SCHED __builtin_amdgcn_sched_barrier(0)
    Unit cur, nxt; int ui = 0;
    if (!S.next(0, cur)) return;
    f32x4 acc[2][2][4][2];
#pragma unroll
    for (int a = 0; a < 2; ++a)
#pragma unroll
        for (int b = 0; b < 2; ++b)
#pragma unroll
            for (int m = 0; m < 4; ++m)
#pragma unroll
                for (int n = 0; n < 2; ++n) acc[a][b][m][n] = (f32x4){0.f, 0.f, 0.f, 0.f};
    bf16x8 At[4][2], B0[2][2], B1[2][2];
    const char* cA = (const char*)g.A + (size_t)cur.pm * tstepA; const char* cB = (const char*)g.Bt + (size_t)cur.pn * tstepB;
    S.a_ready(cur);
    if constexpr (SP2) {
        PG8_STAGE(PG8_SB(0, 0), cB, voffB); PG8_STAGE(PG8_SB(0, 1), cB + hstepB, voffB); PG8_STAGE(PG8_SA(0, 0), cA, voffA); PG8_STAGE(PG8_SA(0, 1), cA + hstepA, voffA);
        if (wr == 1) PG8_BAR;
        PG8_WAIT_V(2); PG8_BAR;
        PG8_STAGE(PG8_SB(1, 0), cB + kstep, voffB); PG8_STAGE(PG8_SA(1, 0), cA + kstep, voffA); PG8_STAGE(PG8_SB(1, 1), cB + hstepB + kstep, voffB);
        PG8_WAIT_V(6); PG8_BAR;
    } else {
        PG8_STAGE(PG8_SB(0, 0), cB, voffB); PG8_STAGE(PG8_SA(0, 0), cA, voffA); PG8_STAGE(PG8_SB(0, 1), cB + hstepB, voffB); PG8_STAGE(PG8_SA(0, 1), cA + hstepA, voffA);
        if (wr == 1) PG8_BAR;
        PG8_WAIT_V(4); PG8_BAR;
        PG8_STAGE(PG8_SB(1, 0), cB + kstep, voffB); PG8_STAGE(PG8_SA(1, 0), cA + kstep, voffA); PG8_STAGE(PG8_SB(1, 1), cB + hstepB + kstep, voffB);
        PG8_WAIT_V(6); PG8_BAR;
    }
    for (;;) {
        const bool has_next = S.next(ui + 1, nxt);
        const char* nA = has_next ? (const char*)g.A + (size_t)nxt.pm * tstepA : cA; const char* nB = has_next ? (const char*)g.Bt + (size_t)nxt.pn * tstepB : cB;
        for (int t = 0; t < nt; t += 2) {
            const bool last = (t == nt - 2);
            const char* a1 = cA + (size_t)(t + 1) * kstep;
            const char* a2 = last ? nA : cA + (size_t)(t + 2) * kstep; const char* b2 = last ? nB : cB + (size_t)(t + 2) * kstep;
            const char* a3 = a2 + kstep; const char* b3 = b2 + kstep;
            if (last && has_next) S.a_ready(nxt);
            if constexpr (SP2) {
            PG8_LDB(B0, 0, 0); PG8_LDB(B1, 0, 1); PG8_SCHED; PG8_LDA(At, 0, 0); PG8_STAGE(PG8_SA(1, 1), a1 + hstepA, voffA);
            PG8_WAIT_V(8); PG8_WAIT_L(0); PG8_BAR; PG8_MMA(0, 0, At, B0); PG8_MMA(0, 1, At, B1); PG8_BAR; PG8_SCHED;
            PG8_LDA(At, 0, 1); PG8_STAGE(PG8_SB(0, 0), b2, voffB); PG8_STAGE(PG8_SB(0, 1), b2 + hstepB, voffB); PG8_STAGE(PG8_SA(0, 0), a2, voffA);
            PG8_WAIT_V(8); PG8_WAIT_L(0); PG8_BAR; PG8_MMA(1, 0, At, B0); PG8_MMA(1, 1, At, B1); PG8_BAR; PG8_SCHED;
            PG8_LDB(B0, 1, 0); PG8_LDB(B1, 1, 1); PG8_SCHED; PG8_LDA(At, 1, 0); PG8_STAGE(PG8_SA(0, 1), a2 + hstepA, voffA);
            PG8_WAIT_V(8); PG8_WAIT_L(0); PG8_BAR; PG8_MMA(0, 0, At, B0); PG8_MMA(0, 1, At, B1); PG8_BAR; PG8_SCHED;
            PG8_LDA(At, 1, 1); PG8_STAGE(PG8_SB(1, 0), b3, voffB); PG8_STAGE(PG8_SB(1, 1), b3 + hstepB, voffB); PG8_STAGE(PG8_SA(1, 0), a3, voffA);
            PG8_WAIT_V(8); PG8_WAIT_L(0); PG8_BAR; PG8_MMA(1, 0, At, B0); PG8_MMA(1, 1, At, B1); PG8_BAR; PG8_SCHED;
            } else {
            PG8_LDB(B0, 0, 0); PG8_SCHED; PG8_LDA(At, 0, 0); PG8_STAGE(PG8_SA(1, 1), a1 + hstepA, voffA);
            PG8_WAIT_L(8); PG8_BAR; PG8_WAIT_L(0); PG8_MMA(0, 0, At, B0); PG8_BAR; PG8_SCHED;
            PG8_LDB(B1, 0, 1); PG8_STAGE(PG8_SB(0, 0), b2, voffB);
            PG8_BAR; PG8_WAIT_L(0); PG8_MMA(0, 1, At, B1); PG8_BAR;
            PG8_LDA(At, 0, 1); PG8_STAGE(PG8_SA(0, 0), a2, voffA);
            PG8_BAR; PG8_WAIT_L(0); PG8_MMA(1, 0, At, B0); PG8_BAR; PG8_SCHED;
            PG8_STAGE(PG8_SB(0, 1), b2 + hstepB, voffB);
            PG8_WAIT_V(6); PG8_BAR; PG8_MMA(1, 1, At, B1); PG8_BAR;
            PG8_LDB(B0, 1, 0); PG8_SCHED; PG8_LDA(At, 1, 0); PG8_STAGE(PG8_SA(0, 1), a2 + hstepA, voffA);
            PG8_WAIT_L(8); PG8_BAR; PG8_WAIT_L(0); PG8_MMA(0, 0, At, B0); PG8_BAR; PG8_SCHED;
            PG8_LDB(B1, 1, 1); PG8_STAGE(PG8_SB(1, 0), b3, voffB);
            PG8_BAR; PG8_WAIT_L(0); PG8_MMA(0, 1, At, B1); PG8_BAR;
            PG8_LDA(At, 1, 1); PG8_STAGE(PG8_SA(1, 0), a3, voffA);
            PG8_BAR; PG8_WAIT_L(0); PG8_MMA(1, 0, At, B0); PG8_BAR; PG8_SCHED;
            PG8_STAGE(PG8_SB(1, 1), b3 + hstepB, voffB);
            PG8_WAIT_V(6); PG8_BAR; PG8_MMA(1, 1, At, B1); PG8_BAR;
            }
        }
        if constexpr (ALIGN_EPI) { if (wr == 0) PG8_BAR; }
        if constexpr (!Epi::AFTER_DRAIN) { E(acc, cur, wr, wc, fr, fq); S.done(cur); }
        if (!has_next) break;
#pragma unroll
        for (int a = 0; a < 2; ++a)
#pragma unroll
            for (int b = 0; b < 2; ++b)
#pragma unroll
                for (int m = 0; m < 4; ++m)
#pragma unroll
                    for (int n = 0; n < 2; ++n) acc[a][b][m][n] = (f32x4){0.f, 0.f, 0.f, 0.f};
        cur = nxt; cA = nA; cB = nB; ++ui;
        if constexpr (ALIGN_EPI) { if (wr == 1) PG8_BAR; }
    }
    PG8_WAIT_V(0);
    if constexpr (!ALIGN_EPI) { if (wr == 0) PG8_BAR; }
    PG8_BAR;
    if constexpr (Epi::AFTER_DRAIN) { E.fused(acc, cur, wr, wc, fr, fq, lds, wid, lane); S.done(cur); }
#undef PG8_SA
#undef PG8_SB
#undef PG8_STAGE
#undef PG8_LDA
#undef PG8_LDB
#undef PG8_MMA
#undef PG8_WAIT_V
#undef PG8_WAIT_L
#undef PG8_BAR
#undef PG8_SCHED
}
}
#ifndef PG8_SP2
#define PG8_SP2 true
#endif
#ifndef PG8_ALIGN
#define PG8_ALIGN true
#endif

constexpr int NWAVES = 8, NTHR = 512;
constexpr int D = 2048, BATCH = 4, SEQ = 4096, CTX = 256, GRIDW = 64;
constexpr int M_LAT = BATCH * SEQ;
constexpr int M_CTX = BATCH * CTX;
constexpr int M_ALL = M_LAT + M_CTX;
constexpr int MIXA = 1024, MIXB = 1024, SGU_G = 4, SGU_P = 128, SGU_GW = 256;
constexpr int GH = 4, GDK = 128, GDV = 256, GKDIM = 512, GLR = 16;
constexpr int N_IN = 5152, N_INP = 5376;
constexpr int C_U = 0, C_VS = 1024, C_Q = 2048, C_K = 2560, C_V = 3072, C_R = 4096, C_LRF = 5120, C_LRB = 5136;
constexpr int DFF = 5632, NUP = 2 * DFF;
constexpr int NMOD = 6, MODW = NMOD * D;
constexpr float EPS = 1e-6f;
constexpr int KSPLIT = 32;

constexpr size_t MiB = 1u << 20;
constexpr size_t WS_CTL = 0, CTL_ZERO_BYTES = 1 * MiB;
constexpr size_t WS_WUP = 1 * MiB;
constexpr size_t WS_WDN = 45 * MiB;
constexpr size_t WS_MOD = 67 * MiB;
constexpr size_t WS_RA  = 68 * MiB;
constexpr size_t WS_RU  = 136 * MiB;
constexpr size_t WS_WIN  = 136 * MiB;
constexpr size_t WS_WOUT = 157 * MiB;
constexpr size_t WS_MODP = 165 * MiB;
constexpr size_t WS_P    = 173 * MiB;
constexpr size_t WS_G    = 352 * MiB;
constexpr size_t WS_VP   = 420 * MiB;
constexpr size_t WS_END  = 488 * MiB;
static_assert(WS_P + (size_t)M_ALL * N_INP * 2 <= WS_G && WS_RU + (size_t)M_LAT * NUP * 2 <= WS_END, "ws map");

constexpr int LDS_BYTES = 147456;
constexpr int MISC_OFF = 131072 + 320;

#define GAS __attribute__((address_space(1)))
#define LAS __attribute__((address_space(3)))
typedef unsigned short bf16;
typedef unsigned v4u __attribute__((ext_vector_type(4)));
typedef unsigned v2u __attribute__((ext_vector_type(2)));
typedef float f32x4 __attribute__((ext_vector_type(4)));
#define LDS_WAIT() asm volatile("s_waitcnt lgkmcnt(0)" ::: "memory")
#define VM_WAIT() asm volatile("s_waitcnt vmcnt(0)" ::: "memory")
__device__ __forceinline__ unsigned f2bf(float f) { unsigned u = __builtin_bit_cast(unsigned, f); return (u + 0x7fffu + ((u >> 16) & 1u)) >> 16; }
__device__ __forceinline__ unsigned pk2(float lo, float hi) { return f2bf(lo) | (f2bf(hi) << 16); }
__device__ __forceinline__ float bf2f(unsigned h) { return __builtin_bit_cast(float, h << 16); }
__device__ __forceinline__ float bflo(unsigned w) { return __builtin_bit_cast(float, w << 16); }
__device__ __forceinline__ float bfhi(unsigned w) { return __builtin_bit_cast(float, w & 0xffff0000u); }
__device__ __forceinline__ float gelu_t(float x) { const float u = 1.5957691216f * (x + 0.044715f * x * x * x); return x / (1.0f + __expf(-u)); }
__device__ __forceinline__ float silu_f(float x) { return x / (1.0f + __expf(-x)); }
__device__ __forceinline__ float wave_sum(float v) {
#pragma unroll
    for (int o = 1; o < 64; o <<= 1) v += __shfl_xor(v, o);
    return v;
}

struct Args {
    const float *x, *c, *ctx, *c_ctx, *ada_w, *ada_b, *pre_mix_g, *post_mix_g, *pre_ffn_g, *post_ffn_g, *w_in, *sgu_ln_g, *sgu_ln_b, *sgu_w, *sgu_b,
                *gate_w_f, *gate_b_f, *gate_w_b, *gate_b_b, *gla_norm_g, *w_out, *w_up, *conv_w, *conv_b, *w_down;
    float* out; unsigned char* ws; int ph_lo, ph_hi;
};
struct Ctx {
    LAS unsigned char* lds; int tid, lane, wave, G, bx;
};

__device__ __forceinline__ void p0_transpose_item(const float* W, int K, int N, bf16* WT, LAS float* scr, int item, int lane) {
    const int nblk = N / 32, kb = item / nblk, nb = item % nblk, k0 = 64 * kb, n0 = 32 * nb;
#pragma unroll 8
    for (int i = 0; i < 32; ++i) { const int kk = 2 * i + (lane >> 5); scr[kk * 33 + (lane & 31)] = W[(size_t)(k0 + kk) * N + n0 + (lane & 31)]; }
    LDS_WAIT(); asm volatile("" ::: "memory");
    const int c = lane & 7;
#pragma unroll
    for (int j = 0; j < 4; ++j) { const int n = (lane >> 3) + 8 * j; const LAS float* s = scr + (8 * c) * 33 + n;
        v4u o; o.x = pk2(s[0 * 33], s[1 * 33]); o.y = pk2(s[2 * 33], s[3 * 33]); o.z = pk2(s[4 * 33], s[5 * 33]); o.w = pk2(s[6 * 33], s[7 * 33]);
        *(GAS v4u*)(WT + (size_t)(n0 + n) * K + k0 + 8 * c) = o; }
    LDS_WAIT(); asm volatile("" ::: "memory");
}

__device__ __forceinline__ void ph_prologue(const Args& a, const Ctx& c) {
    unsigned char* ws = a.ws;
    LAS float* scr = (LAS float*)(c.lds + c.wave * 16384);
    const int gw = c.bx * NWAVES + c.wave, NGW = c.G * NWAVES;
    constexpr int I_IN = (D / 64) * (N_IN / 32), I_OUT = (D / 64) * (D / 32), I_UP = (D / 64) * (NUP / 32), I_DN = (DFF / 64) * (D / 32);
    constexpr int NITEMS = I_IN + I_OUT + I_UP + I_DN;
    for (int it = gw; it < NITEMS; it += NGW) {
        int r = it;
        if (r < I_IN) { p0_transpose_item(a.w_in, D, N_IN, (bf16*)(ws + WS_WIN), scr, r, c.lane); continue; } r -= I_IN;
        if (r < I_OUT) { p0_transpose_item(a.w_out, D, D, (bf16*)(ws + WS_WOUT), scr, r, c.lane); continue; } r -= I_OUT;
        if (r < I_UP) { p0_transpose_item(a.w_up, D, NUP, (bf16*)(ws + WS_WUP), scr, r, c.lane); continue; } r -= I_UP;
        p0_transpose_item(a.w_down, DFF, D, (bf16*)(ws + WS_WDN), scr, r, c.lane);
    }
    { GAS v4u* z = (GAS v4u*)(ws + WS_WIN + (size_t)N_IN * D * 2); const int n16 = (N_INP - N_IN) * D * 2 / 16;
      for (int i = c.bx * NTHR + c.tid; i < n16; i += c.G * NTHR) z[i] = (v4u){0u, 0u, 0u, 0u}; }
    { float* modp = (float*)(ws + WS_MODP);
      for (int it = c.bx; it < KSPLIT * (MODW / NTHR); it += c.G) {
          const int kb = it / (MODW / NTHR), jb = it % (MODW / NTHR), j = jb * NTHR + c.tid;
          float acc[5] = {0.f, 0.f, 0.f, 0.f, 0.f};
          for (int k = kb * 64; k < kb * 64 + 64; ++k) {
              const float w = a.ada_w[(size_t)k * MODW + j];
#pragma unroll
              for (int r = 0; r < 5; ++r) { const float cv = (r < 4) ? a.c[r * D + k] : a.c_ctx[k]; acc[r] += silu_f(cv) * w; }
          }
#pragma unroll
          for (int r = 0; r < 5; ++r) modp[((size_t)kb * 5 + r) * MODW + j] = acc[r];
      } }
}

__device__ __forceinline__ void ph_modreduce(const Args& a, const Ctx& c) {
    const float* modp = (const float*)(a.ws + WS_MODP); float* mod = (float*)(a.ws + WS_MOD);
    for (int i = c.bx * NTHR + c.tid; i < 5 * MODW; i += c.G * NTHR) {
        const int j = i % MODW; float s = a.ada_b[j];
        for (int kb = 0; kb < KSPLIT; ++kb) s += modp[(size_t)kb * 5 * MODW + i];
        mod[i] = s;
    }
}

__device__ __forceinline__ void ph_prenorm(const Args& a, const Ctx& c) {
    const float* mod = (const float*)(a.ws + WS_MOD); bf16* A1 = (bf16*)(a.ws + WS_RA);
    const int gw = c.bx * NWAVES + c.wave, NGW = c.G * NWAVES;
    for (int m = gw; m < M_ALL; m += NGW) {
        const float* xr; int mr;
        if (m < M_LAT) { xr = a.x + (size_t)m * D; mr = m / SEQ; } else { xr = a.ctx + (size_t)(m - M_LAT) * D; mr = 4; }
        const float* sh = mod + (size_t)mr * MODW; const float* sc = sh + D;
        f32x4 v[8]; float s = 0.f;
#pragma unroll
        for (int j = 0; j < 8; ++j) { v[j] = *(const f32x4*)(xr + 4 * c.lane + 256 * j); s += (v[j].x * v[j].x + v[j].y * v[j].y) + (v[j].z * v[j].z + v[j].w * v[j].w); }
        const float rstd = 1.0f / sqrtf(wave_sum(s) * (1.0f / D) + EPS);
#pragma unroll
        for (int j = 0; j < 8; ++j) { const int col = 4 * c.lane + 256 * j;
            const f32x4 g = *(const f32x4*)(a.pre_mix_g + col), s1 = *(const f32x4*)(sc + col), s0 = *(const f32x4*)(sh + col);
            const f32x4 o = v[j] * rstd * g * (1.0f + s1) + s0;
            v2u w; w.x = pk2(o.x, o.y); w.y = pk2(o.z, o.w); *(v2u*)(A1 + (size_t)m * D + col) = w; }
    }
}

__device__ __forceinline__ float logsigmoid_f(float z) { return fminf(z, 0.f) - log1pf(expf(-fabsf(z))); }

__device__ __forceinline__ void ph_gates_vp(const Args& a, const Ctx& c) {
    const bf16* P = (const bf16*)(a.ws + WS_P); float* Gt = (float*)(a.ws + WS_G); bf16* VP = (bf16*)(a.ws + WS_VP);
    for (int it = c.bx; it < 2 * M_ALL; it += c.G) {
        const int row = it >> 1, dir = it & 1; const float* W = dir ? a.gate_w_b : a.gate_w_f; const float* Bv = dir ? a.gate_b_b : a.gate_b_f;
        float z = Bv[c.tid];
#pragma unroll
        for (int j = 0; j < GLR; ++j) z += bf2f(P[(size_t)row * N_INP + C_LRF + dir * GLR + j]) * W[j * GKDIM + c.tid];
        Gt[((size_t)dir * M_ALL + row) * GKDIM + c.tid] = logsigmoid_f(z) * (1.0f / 16.0f);
    }
    const int gw = c.bx * NWAVES + c.wave, NGW = c.G * NWAVES;
    for (int it = gw; it < M_LAT * SGU_G; it += NGW) {
        const int row = it >> 2, g = it & 3; const int col = g * SGU_GW + 4 * c.lane;
        const v2u w = *(const v2u*)(P + (size_t)row * N_INP + C_VS + col);
        float v0 = gelu_t(bflo(w.x)), v1 = gelu_t(bfhi(w.x)), v2 = gelu_t(bflo(w.y)), v3 = gelu_t(bfhi(w.y));
        const float mu = wave_sum((v0 + v1) + (v2 + v3)) * (1.0f / SGU_GW);
        v0 -= mu; v1 -= mu; v2 -= mu; v3 -= mu;
        const float rstd = 1.0f / sqrtf(wave_sum((v0 * v0 + v1 * v1) + (v2 * v2 + v3 * v3)) * (1.0f / SGU_GW) + EPS);
        const f32x4 lg = *(const f32x4*)(a.sgu_ln_g + col), lb = *(const f32x4*)(a.sgu_ln_b + col);
        v2u o; o.x = pk2(v0 * rstd * lg.x + lb.x, v1 * rstd * lg.y + lb.y); o.y = pk2(v2 * rstd * lg.z + lb.z, v3 * rstd * lg.w + lb.w);
        *(v2u*)(VP + (size_t)row * MIXA + col) = o;
    }
}

__device__ __forceinline__ void ph_mix_naive(const Args& a, const Ctx& c) {
    const bf16* P = (const bf16*)(a.ws + WS_P); const float* Gt = (const float*)(a.ws + WS_G); const bf16* VP = (const bf16*)(a.ws + WS_VP);
    bf16* YC = (bf16*)(a.ws + WS_RA); float* O = a.out;
    for (int it = c.bx; it < M_LAT * 2; it += c.G) {
        const int row = it >> 1, g = 2 * (it & 1) + (c.tid >> 8), ch = g * SGU_GW + (c.tid & 255);
        const int b = row / SEQ, t = row % SEQ, n = t / SGU_P, p = t % SGU_P;
        const float* wr = a.sgu_w + ((size_t)g * SGU_P + p) * SGU_P; const bf16* vp = VP + ((size_t)b * SEQ + n * SGU_P) * MIXA + ch;
        float s = a.sgu_b[g * SGU_P + p];
        for (int q = 0; q < SGU_P; ++q) s += wr[q] * bf2f(vp[(size_t)q * MIXA]);
        const float u = gelu_t(bf2f(P[(size_t)row * N_INP + C_U + ch]));
        YC[(size_t)row * D + ch] = (bf16)f2bf(u * s);
    }
    if (c.bx < 16) {
        constexpr int TB = 16;
        const int half = c.tid >> 8, v = c.tid & 255, chain = c.bx * 2 + half, b = chain >> 3, h = (chain >> 1) & 3, dir = chain & 1;
        LAS float* st = (LAS float*)c.lds + half * (TB * 384);
        float S[GDK];
#pragma unroll
        for (int d = 0; d < GDK; ++d) S[d] = 0.f;
        for (int i0 = 0; i0 < CTX + SEQ; i0 += TB) {
            __syncthreads();
            for (int idx = v; idx < TB * 384; idx += 256) {
                const int tt = idx / 384, e = idx % 384, i = i0 + tt;
                const int row = (i < CTX) ? (M_LAT + b * CTX + (dir ? CTX - 1 - i : i)) : (b * SEQ + (dir ? SEQ - 1 - (i - CTX) : (i - CTX)));
                float val;
                if (e < 128) val = bf2f(P[(size_t)row * N_INP + C_Q + h * GDK + e]) * 0.08838834764831845f;
                else if (e < 256) val = bf2f(P[(size_t)row * N_INP + C_K + h * GDK + (e - 128)]);
                else val = expf(Gt[((size_t)dir * M_ALL + row) * GKDIM + h * GDK + (e - 256)]);
                st[idx] = val;
            }
            __syncthreads();
            for (int tt = 0; tt < TB; ++tt) {
                const int i = i0 + tt;
                const int row = (i < CTX) ? (M_LAT + b * CTX + (dir ? CTX - 1 - i : i)) : (b * SEQ + (dir ? SEQ - 1 - (i - CTX) : (i - CTX)));
                const float vv = bf2f(P[(size_t)row * N_INP + C_V + h * GDV + v]);
                const LAS float* q = st + tt * 384; float o = 0.f;
#pragma unroll
                for (int d = 0; d < GDK; ++d) { S[d] = q[256 + d] * S[d] + q[128 + d] * vv; o += q[d] * S[d]; }
                if (i >= CTX) O[((size_t)dir * M_LAT + row) * MIXB + h * GDV + v] = o;
            }
        }
    }
}

__device__ __forceinline__ void ph_combine(const Args& a, const Ctx& c) {
    const bf16* P = (const bf16*)(a.ws + WS_P); bf16* YC = (bf16*)(a.ws + WS_RA); const float* O = a.out;
    const int gw = c.bx * NWAVES + c.wave, NGW = c.G * NWAVES;
    for (int it = gw; it < M_LAT * GH; it += NGW) {
        const int row = it >> 2, h = it & 3, col = h * GDV + 4 * c.lane;
        const f32x4 of = *(const f32x4*)(O + (size_t)row * MIXB + col), ob = *(const f32x4*)(O + ((size_t)M_LAT + row) * MIXB + col);
        const f32x4 o = of + ob;
        const float rstd = 1.0f / sqrtf(wave_sum((o.x * o.x + o.y * o.y) + (o.z * o.z + o.w * o.w)) * (1.0f / GDV) + EPS);
        const f32x4 ng = *(const f32x4*)(a.gla_norm_g + 4 * c.lane);
        const v2u rw = *(const v2u*)(P + (size_t)row * N_INP + C_R + col);
        v2u w; w.x = pk2(o.x * rstd * ng.x * silu_f(bflo(rw.x)), o.y * rstd * ng.y * silu_f(bfhi(rw.x)));
        w.y = pk2(o.z * rstd * ng.z * silu_f(bflo(rw.y)), o.w * rstd * ng.w * silu_f(bfhi(rw.y)));
        *(v2u*)(YC + (size_t)row * D + MIXA + col) = w;
    }
}

__device__ __forceinline__ void ph_mid(const Args& a, const Ctx& c) {
    const float* mod = (const float*)(a.ws + WS_MOD); const bf16* Y = (const bf16*)(a.ws + WS_P); bf16* Fo = (bf16*)(a.ws + WS_RA);
    const int gw = c.bx * NWAVES + c.wave, NGW = c.G * NWAVES;
    for (int m = gw; m < M_LAT; m += NGW) {
        const float* mr = mod + (size_t)(m / SEQ) * MODW; const float *gtm = mr + 2 * D, *shf = mr + 3 * D, *scf = mr + 4 * D;
        f32x4 y[8]; float s = 0.f;
#pragma unroll
        for (int j = 0; j < 8; ++j) { const v2u w = *(const v2u*)(Y + (size_t)m * D + 4 * c.lane + 256 * j); y[j] = (f32x4){bflo(w.x), bfhi(w.x), bflo(w.y), bfhi(w.y)};
            s += (y[j].x * y[j].x + y[j].y * y[j].y) + (y[j].z * y[j].z + y[j].w * y[j].w); }
        const float rstd = 1.0f / sqrtf(wave_sum(s) * (1.0f / D) + EPS); float s2 = 0.f;
#pragma unroll
        for (int j = 0; j < 8; ++j) { const int col = 4 * c.lane + 256 * j;
            const f32x4 xv = *(const f32x4*)(a.x + (size_t)m * D + col), g = *(const f32x4*)(a.post_mix_g + col), gt = *(const f32x4*)(gtm + col);
            y[j] = xv + gt * (y[j] * rstd * g); *(f32x4*)(a.out + (size_t)m * D + col) = y[j];
            s2 += (y[j].x * y[j].x + y[j].y * y[j].y) + (y[j].z * y[j].z + y[j].w * y[j].w); }
        const float rstd2 = 1.0f / sqrtf(wave_sum(s2) * (1.0f / D) + EPS);
#pragma unroll
        for (int j = 0; j < 8; ++j) { const int col = 4 * c.lane + 256 * j;
            const f32x4 g = *(const f32x4*)(a.pre_ffn_g + col), s1 = *(const f32x4*)(scf + col), s0 = *(const f32x4*)(shf + col);
            const f32x4 o = y[j] * rstd2 * g * (1.0f + s1) + s0;
            v2u w; w.x = pk2(o.x, o.y); w.y = pk2(o.z, o.w); *(v2u*)(Fo + (size_t)m * D + col) = w; }
    }
}

__device__ __forceinline__ void ph_conv(const Args& a, const Ctx& c) {
    bf16* U = (bf16*)(a.ws + WS_RU);
    constexpr int CH = DFF / 8;
    for (long idx = (long)c.bx * NTHR + c.tid; idx < (long)M_LAT * CH; idx += (long)c.G * NTHR) {
        const int m = (int)(idx / CH), ch = (int)(idx % CH) * 8, b = m / SEQ, t = m % SEQ, gi = t / GRIDW, gj = t % GRIDW;
        float acc[8];
        { const f32x4 b0 = *(const f32x4*)(a.conv_b + ch), b1 = *(const f32x4*)(a.conv_b + ch + 4);
          acc[0] = b0.x; acc[1] = b0.y; acc[2] = b0.z; acc[3] = b0.w; acc[4] = b1.x; acc[5] = b1.y; acc[6] = b1.z; acc[7] = b1.w; }
#pragma unroll
        for (int di = 0; di < 3; ++di)
#pragma unroll
            for (int dj = 0; dj < 3; ++dj) {
                const int ii = gi + di - 1, jj = gj + dj - 1;
                if (ii < 0 || ii >= GRIDW || jj < 0 || jj >= GRIDW) continue;
                const v4u w = *(const v4u*)(U + ((size_t)b * SEQ + ii * GRIDW + jj) * NUP + ch);
                const f32x4 k0 = *(const f32x4*)(a.conv_w + (size_t)(di * 3 + dj) * DFF + ch), k1 = *(const f32x4*)(a.conv_w + (size_t)(di * 3 + dj) * DFF + ch + 4);
                acc[0] += bflo(w.x) * k0.x; acc[1] += bfhi(w.x) * k0.y; acc[2] += bflo(w.y) * k0.z; acc[3] += bfhi(w.y) * k0.w;
                acc[4] += bflo(w.z) * k1.x; acc[5] += bfhi(w.z) * k1.y; acc[6] += bflo(w.w) * k1.z; acc[7] += bfhi(w.w) * k1.w;
            }
        const v4u vw = *(const v4u*)(U + (size_t)m * NUP + DFF + ch);
        v4u o; o.x = pk2(gelu_t(acc[0]) * bflo(vw.x), gelu_t(acc[1]) * bfhi(vw.x)); o.y = pk2(gelu_t(acc[2]) * bflo(vw.y), gelu_t(acc[3]) * bfhi(vw.y));
        o.z = pk2(gelu_t(acc[4]) * bflo(vw.z), gelu_t(acc[5]) * bfhi(vw.z)); o.w = pk2(gelu_t(acc[6]) * bflo(vw.w), gelu_t(acc[7]) * bfhi(vw.w));
        *(v4u*)(U + (size_t)m * NUP + DFF + ch) = o;
    }
}

__device__ __forceinline__ void ph_final(const Args& a, const Ctx& c) {
    const float* mod = (const float*)(a.ws + WS_MOD); const bf16* Z = (const bf16*)(a.ws + WS_RA);
    const int gw = c.bx * NWAVES + c.wave, NGW = c.G * NWAVES;
    for (int m = gw; m < M_LAT; m += NGW) {
        const float* gtf = mod + (size_t)(m / SEQ) * MODW + 5 * D;
        f32x4 z[8]; float s = 0.f;
#pragma unroll
        for (int j = 0; j < 8; ++j) { const v2u w = *(const v2u*)(Z + (size_t)m * D + 4 * c.lane + 256 * j); z[j] = (f32x4){bflo(w.x), bfhi(w.x), bflo(w.y), bfhi(w.y)};
            s += (z[j].x * z[j].x + z[j].y * z[j].y) + (z[j].z * z[j].z + z[j].w * z[j].w); }
        const float rstd = 1.0f / sqrtf(wave_sum(s) * (1.0f / D) + EPS);
#pragma unroll
        for (int j = 0; j < 8; ++j) { const int col = 4 * c.lane + 256 * j;
            const f32x4 hv = *(const f32x4*)(a.out + (size_t)m * D + col), g = *(const f32x4*)(a.post_ffn_g + col), gt = *(const f32x4*)(gtf + col);
            *(f32x4*)(a.out + (size_t)m * D + col) = hv + gt * (z[j] * rstd * g); }
    }
}

constexpr int N_PHASES = 13;
__global__ void __launch_bounds__(NTHR, 2) mk_fwd(Args a) {
    extern __shared__ __attribute__((aligned(16))) unsigned char lds_raw[];
    Ctx c; c.lds = (LAS unsigned char*)lds_raw; c.tid = threadIdx.x; c.lane = c.tid & 63; c.wave = __builtin_amdgcn_readfirstlane(c.tid >> 6); c.G = gridDim.x; c.bx = blockIdx.x;
    const int lo = a.ph_lo, hi = a.ph_hi;
#define IN(k) (lo <= (k) && (k) < hi)
#define SEAM(k) do { if (IN(k) && IN((k) + 1)) { cg::this_grid().sync(); } } while (0)
    typedef pg8::EpiBf16<0> EpiB;
    if (IN(0)) { ph_prologue(a, c); } SEAM(0);
    if (IN(1)) { ph_modreduce(a, c); } SEAM(1);
    if (IN(2)) { ph_prenorm(a, c); } SEAM(2);
    if (IN(3)) {
        pg8::Gemm g{(const bf16*)(a.ws + WS_RA), (const bf16*)(a.ws + WS_WIN), M_ALL, N_INP, D, D}; pg8::StaticOrder S; S.init(M_ALL, N_INP, c.G, c.bx);
        EpiB E{(bf16*)(a.ws + WS_P), N_INP, nullptr, 0, 0, 1.f};
        pg8::gemm_phase<EpiB, pg8::StaticOrder, PG8_ALIGN, PG8_SP2>(c.lds, g, S, E);
    } SEAM(3);
    if (IN(4)) { ph_gates_vp(a, c); } SEAM(4);
    if (IN(5)) { ph_mix_naive(a, c); } SEAM(5);
    if (IN(6)) { ph_combine(a, c); } SEAM(6);
    if (IN(7)) {
        pg8::Gemm g{(const bf16*)(a.ws + WS_RA), (const bf16*)(a.ws + WS_WOUT), M_LAT, D, D, D}; pg8::StaticOrder S; S.init(M_LAT, D, c.G, c.bx);
        EpiB E{(bf16*)(a.ws + WS_P), D, nullptr, 0, 0, 1.f};
        pg8::gemm_phase<EpiB, pg8::StaticOrder, PG8_ALIGN, PG8_SP2>(c.lds, g, S, E);
    } SEAM(7);
    if (IN(8)) { ph_mid(a, c); } SEAM(8);
    if (IN(9)) {
        pg8::Gemm g{(const bf16*)(a.ws + WS_RA), (const bf16*)(a.ws + WS_WUP), M_LAT, NUP, D, D}; pg8::StaticOrder S; S.init(M_LAT, NUP, c.G, c.bx);
        EpiB E{(bf16*)(a.ws + WS_RU), NUP, nullptr, 0, 0, 1.f};
        pg8::gemm_phase<EpiB, pg8::StaticOrder, PG8_ALIGN, PG8_SP2>(c.lds, g, S, E);
    } SEAM(9);
    if (IN(10)) { ph_conv(a, c); } SEAM(10);
    if (IN(11)) {
        pg8::Gemm g{(const bf16*)(a.ws + WS_RU) + DFF, (const bf16*)(a.ws + WS_WDN), M_LAT, D, DFF, NUP}; pg8::StaticOrder S; S.init(M_LAT, D, c.G, c.bx);
        EpiB E{(bf16*)(a.ws + WS_RA), D, nullptr, 0, 0, 1.f};
        pg8::gemm_phase<EpiB, pg8::StaticOrder, PG8_ALIGN, PG8_SP2>(c.lds, g, S, E);
    } SEAM(11);
    if (IN(12)) { ph_final(a, c); }
#undef IN
#undef SEAM
}

#ifndef MK_ONE_LAUNCH
#define MK_ONE_LAUNCH 0
#endif
extern "C" void kernel_launch(void* const* d_in, const int* in_sizes, int n_in, void* d_out, int out_size, void* d_ws, size_t ws_size, hipStream_t stream) {
    static int grid = 0;
    if (grid == 0) {
        if (n_in != 25 || in_sizes[0] != M_LAT * D || out_size != M_LAT * D || ws_size < WS_END) { fprintf(stderr, "kernel_launch: unexpected shapes (n_in %d, ws %zu)\n", n_in, ws_size); grid = -1; return; }
        int dev = 0, cus = 0, per_cu = 0;
        (void)hipGetDevice(&dev); (void)hipDeviceGetAttribute(&cus, hipDeviceAttributeMultiprocessorCount, dev);
        (void)hipFuncSetAttribute((const void*)mk_fwd, hipFuncAttributeMaxDynamicSharedMemorySize, LDS_BYTES);
        (void)hipOccupancyMaxActiveBlocksPerMultiprocessor(&per_cu, (const void*)mk_fwd, NTHR, LDS_BYTES);
        (void)hipGetLastError();
        if (per_cu < 1) { fprintf(stderr, "kernel_launch: occupancy query says %d blocks per CU\n", per_cu); grid = -1; return; }
        grid = cus;
    }
    if (grid < 0) return;
    Args a{};
    const float** f = (const float**)&a;
    for (int i = 0; i < 25; ++i) f[i] = (const float*)d_in[i];
    a.out = (float*)d_out; a.ws = (unsigned char*)d_ws;
    (void)hipMemsetAsync((char*)d_ws + WS_CTL, 0, CTL_ZERO_BYTES, stream);
#if MK_ONE_LAUNCH
    a.ph_lo = 0; a.ph_hi = N_PHASES;
    void* args[] = {&a};
    hipError_t e = hipLaunchCooperativeKernel((const void*)mk_fwd, dim3(grid), dim3(NTHR), args, LDS_BYTES, stream);
    if (e != hipSuccess) fprintf(stderr, "cooperative launch failed: %s (grid %d)\n", hipGetErrorString(e), grid);
#else
    for (int p = 0; p < N_PHASES; ++p) { a.ph_lo = p; a.ph_hi = p + 1; hipLaunchKernelGGL(mk_fwd, dim3(grid), dim3(NTHR), LDS_BYTES, stream, a); }
#endif
}
```

```cpp
#include <hip/hip_runtime.h>
#include <hip/hip_cooperative_groups.h>
#include <cstdio>
#include <cstdint>
namespace cg = cooperative_groups;
namespace pg8 {
#define PG8_LAS __attribute__((address_space(3)))
typedef unsigned short bf16_t;
typedef short bf16x8 __attribute__((ext_vector_type(8)));
typedef float f32x4 __attribute__((ext_vector_type(4)));
typedef unsigned u32x4 __attribute__((ext_vector_type(4)));
constexpr int BM = 256, BK = 64, HALF = 128, HTB = HALF * BK * 2  , STAGE_BYTES = 8 * HTB, NXCD = 8, WGM = 8;

__host__ __device__ __forceinline__ int lds_byte(int r, int c) { const int st = (r >> 4) * 2 + (c >> 5), rr = r & 15, cc = c & 31, ob = rr * 64 + cc * 2; return st * 1024 + (ob ^ (((ob >> 9) & 1) << 5)); }
__host__ __device__ __forceinline__ void stage_rc(int b, int& R, int& C) { const int st = b / 1024, sb = b % 1024, swz = sb ^ (((sb >> 9) & 1) << 5); R = (st >> 1) * 16 + swz / 64; C = (st & 1) * 32 + (swz % 64) / 2; }
__host__ __device__ __forceinline__ int perm32(int rho) { const int n = rho >> 4, i = rho & 15; return 8 * (i >> 2) + 4 * n + (i & 3); }

struct Unit { int pm, pn; };
struct Gemm { const bf16_t* A; const bf16_t* Bt; int M, N, K, lda; };

struct StaticOrder {
    int nM, nN, nwg, G, c;
    __host__ __device__ void init(int M, int N, int G_, int c_) { nM = M / BM; nN = N / BM; nwg = nM * nN; G = G_; c = c_; }
    __host__ __device__ bool next(int i, Unit& u) const {
        const long L = (long)i * G + c; if (L >= nwg) return false;
        int wgid = (int)L; { const int q = nwg / NXCD, r = nwg % NXCD, xcd = wgid % NXCD, off = wgid / NXCD; wgid = (xcd < r ? xcd * (q + 1) : r * (q + 1) + (xcd - r) * q) + off; }
        const int nig = WGM * nN, gid = wgid / nig, fm = gid * WGM, gsz = (nM - fm) < WGM ? (nM - fm) : WGM;
        u.pm = fm + ((wgid % nig) % gsz); u.pn = (wgid % nig) / gsz; return true;
    }
    __device__ __forceinline__ void a_ready(const Unit&) const {}
    __device__ __forceinline__ void done(const Unit&) const {}
};

__device__ __forceinline__ unsigned cvt_pk_bf16(float lo, float hi) { unsigned r; asm volatile("v_cvt_pk_bf16_f32 %0, %1, %2" : "=v"(r) : "v"(lo), "v"(hi)); return r; }
typedef float f32x2 __attribute__((ext_vector_type(2)));
__device__ __forceinline__ f32x2 gelu_pk(f32x2 v) {
    const f32x2 av = __builtin_elementwise_abs(v), d = av * 0.2316418882f + 1.0f;
    f32x2 t; t.x = __builtin_amdgcn_rcpf(d.x); t.y = __builtin_amdgcn_rcpf(d.y);
    f32x2 q = t * 0.5307027145f + (-0.7265760135f); q = q * t + 0.7107068705f; q = q * t + (-0.142248368f); q = q * t + 0.127414796f; q = q * t;
    const f32x2 s = (v * v) * (-0.72134752044f);
    f32x2 e; e.x = __builtin_amdgcn_exp2f(s.x); e.y = __builtin_amdgcn_exp2f(s.y);
    const f32x2 m = v * (q * e), r = v - m;
    f32x2 o; o.x = v.x < 0.f ? m.x : r.x; o.y = v.y < 0.f ? m.y : r.y; return o;
}

template <int ACT  > struct EpiBf16 {
    static constexpr bool PERM = true, AFTER_DRAIN = false; static_assert(ACT == 0 || ACT == 1, "EpiBf16: ACT is 0 (none) or 1 (gelu_pk)");
    bf16_t* O; int ldc; const float* bias; int split_cols; size_t split_stride; float scale0;
    __device__ __forceinline__ void operator()(const f32x4 (&acc)[2][2][4][2], const Unit& u, int wr, int wc, int fr, int fq) const {
        const int row0 = u.pm * BM + wr * 64 + fr; int colt = u.pn * BM; bf16_t* base = O;
        float sc = 1.f; if (split_cols) { const int t = colt / split_cols; base += (size_t)t * split_stride; colt -= t * split_cols; if (t == 0) sc = scale0; }
        const int col0 = colt + wc * 32 + 8 * fq, bcol0 = u.pn * BM + wc * 32 + 8 * fq;
        f32x4 bv[2][2];
#pragma unroll
        for (int bj = 0; bj < 2; ++bj)
#pragma unroll
            for (int n = 0; n < 2; ++n) bv[bj][n] = bias ? *(const f32x4*)(bias + bcol0 + bj * HALF + 4 * n) : (f32x4){0.f, 0.f, 0.f, 0.f};
#pragma unroll
        for (int ai = 0; ai < 2; ++ai)
#pragma unroll
            for (int m = 0; m < 4; ++m) { bf16_t* rowp = base + (size_t)(row0 + ai * HALF + m * 16) * ldc + col0;
#pragma unroll
                for (int bj = 0; bj < 2; ++bj) { f32x4 v0 = acc[ai][bj][m][0] + bv[bj][0], v1 = acc[ai][bj][m][1] + bv[bj][1];
                    if (ACT == 1) { f32x2 a = gelu_pk((f32x2){v0[0], v0[1]}), b = gelu_pk((f32x2){v0[2], v0[3]}), c = gelu_pk((f32x2){v1[0], v1[1]}), d = gelu_pk((f32x2){v1[2], v1[3]});
                        v0 = (f32x4){a.x, a.y, b.x, b.y}; v1 = (f32x4){c.x, c.y, d.x, d.y}; }
                    v0 = v0 * sc; v1 = v1 * sc; u32x4 w; w.x = cvt_pk_bf16(v0[0], v0[1]); w.y = cvt_pk_bf16(v0[2], v0[3]); w.z = cvt_pk_bf16(v1[0], v1[1]); w.w = cvt_pk_bf16(v1[2], v1[3]);
                    *(u32x4*)(rowp + bj * HALF) = w; } }
    }
};
template <class Epi, class Sched, bool ALIGN_EPI = false, bool SP2 = false>
__device__ __forceinline__ void gemm_phase(PG8_LAS unsigned char* lds, const Gemm g, const Sched& S, const Epi& E) {
    const int tid = threadIdx.x, wid = __builtin_amdgcn_readfirstlane(tid >> 6), lane = tid & 63, wr = wid >> 2, wc = wid & 3, fr = lane & 15, fq = lane >> 4;
    const int K = g.K, nt = K / BK, LDA = g.lda;
    unsigned voffA[2], voffB[2];
#pragma unroll
    for (int i = 0; i < 2; ++i) { int R, C; stage_rc(tid * 16 + i * 8192, R, C); const int Rb = Epi::PERM ? ((R & ~31) + perm32(R & 31)) : R;
        voffA[i] = (unsigned)(R * LDA + C) * 2u; voffB[i] = (unsigned)(Rb * K + C) * 2u; }
    const size_t kstep = (size_t)(BK * 2);
    const size_t hstepB = (size_t)HALF * K * 2, hstepA = (size_t)HALF * LDA * 2;
    const size_t tstepB = 2 * hstepB, tstepA = 2 * hstepA;
    const unsigned ldsw = (unsigned)wid * 1024u;
    const int aoff = lds_byte(wr * 64 + fr, fq * 8), boff = lds_byte(wc * 32 + fr, fq * 8);
#define PG8_SA(b, h) (((b) * 2 + (h)) * HTB)
#define PG8_SB(b, h) ((4 + (b) * 2 + (h)) * HTB)
#define PG8_STAGE(bufoff, gbase, voff) do { _Pragma("unroll") for (int _i = 0; _i < 2; ++_i) \
        __builtin_amdgcn_global_load_lds((const unsigned*)((const char*)(gbase) + (voff)[_i]), (PG8_LAS unsigned*)(lds + (bufoff) + ldsw + _i * 8192), 16, 0, 0); } while (0)
#define PG8_LDA(dst, b, h) do { _Pragma("unroll") for (int m = 0; m < 4; ++m) _Pragma("unroll") for (int k = 0; k < 2; ++k) dst[m][k] = *(const PG8_LAS bf16x8*)(lds + PG8_SA(b, h) + aoff + m * 2048 + k * 1024); } while (0)
#define PG8_LDB(dst, b, h) do { _Pragma("unroll") for (int n = 0; n < 2; ++n) _Pragma("unroll") for (int k = 0; k < 2; ++k) dst[n][k] = *(const PG8_LAS bf16x8*)(lds + PG8_SB(b, h) + boff + n * 2048 + k * 1024); } while (0)
#define PG8_MMA(ai, bj, At, Bt) do { __builtin_amdgcn_s_setprio(1); _Pragma("unroll") for (int m = 0; m < 4; ++m) _Pragma("unroll") for (int n = 0; n < 2; ++n) _Pragma("unroll") for (int k = 0; k < 2; ++k) \
        acc[ai][bj][m][n] = __builtin_amdgcn_mfma_f32_16x16x32_bf16(Bt[n][k], At[m][k], acc[ai][bj][m][n], 0, 0, 0); __builtin_amdgcn_s_setprio(0); } while (0)
#define PG8_WAIT_V(n) asm volatile("s_waitcnt vmcnt(" #n ")" ::: "memory")
#define PG8_WAIT_L(n) asm volatile("s_waitcnt lgkmcnt(" #n ")" ::: "memory")
#define PG8_BAR __builtin_amdgcn_s_barrier()
#define PG8_SCHED __builtin_amdgcn_sched_barrier(0)
    Unit cur, nxt; int ui = 0;
    if (!S.next(0, cur)) return;
    f32x4 acc[2][2][4][2];
#pragma unroll
    for (int a = 0; a < 2; ++a)
#pragma unroll
        for (int b = 0; b < 2; ++b)
#pragma unroll
            for (int m = 0; m < 4; ++m)
#pragma unroll
                for (int n = 0; n < 2; ++n) acc[a][b][m][n] = (f32x4){0.f, 0.f, 0.f, 0.f};
    bf16x8 At[4][2], B0[2][2], B1[2][2];
    const char* cA = (const char*)g.A + (size_t)cur.pm * tstepA; const char* cB = (const char*)g.Bt + (size_t)cur.pn * tstepB;
    S.a_ready(cur);
    if constexpr (SP2) {
        PG8_STAGE(PG8_SB(0, 0), cB, voffB); PG8_STAGE(PG8_SB(0, 1), cB + hstepB, voffB); PG8_STAGE(PG8_SA(0, 0), cA, voffA); PG8_STAGE(PG8_SA(0, 1), cA + hstepA, voffA);
        if (wr == 1) PG8_BAR;
        PG8_WAIT_V(2); PG8_BAR;
        PG8_STAGE(PG8_SB(1, 0), cB + kstep, voffB); PG8_STAGE(PG8_SA(1, 0), cA + kstep, voffA); PG8_STAGE(PG8_SB(1, 1), cB + hstepB + kstep, voffB);
        PG8_WAIT_V(6); PG8_BAR;
    } else {
        PG8_STAGE(PG8_SB(0, 0), cB, voffB); PG8_STAGE(PG8_SA(0, 0), cA, voffA); PG8_STAGE(PG8_SB(0, 1), cB + hstepB, voffB); PG8_STAGE(PG8_SA(0, 1), cA + hstepA, voffA);
        if (wr == 1) PG8_BAR;
        PG8_WAIT_V(4); PG8_BAR;
        PG8_STAGE(PG8_SB(1, 0), cB + kstep, voffB); PG8_STAGE(PG8_SA(1, 0), cA + kstep, voffA); PG8_STAGE(PG8_SB(1, 1), cB + hstepB + kstep, voffB);
        PG8_WAIT_V(6); PG8_BAR;
    }
    for (;;) {
        const bool has_next = S.next(ui + 1, nxt);
        const char* nA = has_next ? (const char*)g.A + (size_t)nxt.pm * tstepA : cA; const char* nB = has_next ? (const char*)g.Bt + (size_t)nxt.pn * tstepB : cB;
        for (int t = 0; t < nt; t += 2) {
            const bool last = (t == nt - 2);
            const char* a1 = cA + (size_t)(t + 1) * kstep;
            const char* a2 = last ? nA : cA + (size_t)(t + 2) * kstep; const char* b2 = last ? nB : cB + (size_t)(t + 2) * kstep;
            const char* a3 = a2 + kstep; const char* b3 = b2 + kstep;
            if (last && has_next) S.a_ready(nxt);
            if constexpr (SP2) {
            PG8_LDB(B0, 0, 0); PG8_LDB(B1, 0, 1); PG8_SCHED; PG8_LDA(At, 0, 0); PG8_STAGE(PG8_SA(1, 1), a1 + hstepA, voffA);
            PG8_WAIT_V(8); PG8_WAIT_L(0); PG8_BAR; PG8_MMA(0, 0, At, B0); PG8_MMA(0, 1, At, B1); PG8_BAR; PG8_SCHED;
            PG8_LDA(At, 0, 1); PG8_STAGE(PG8_SB(0, 0), b2, voffB); PG8_STAGE(PG8_SB(0, 1), b2 + hstepB, voffB); PG8_STAGE(PG8_SA(0, 0), a2, voffA);
            PG8_WAIT_V(8); PG8_WAIT_L(0); PG8_BAR; PG8_MMA(1, 0, At, B0); PG8_MMA(1, 1, At, B1); PG8_BAR; PG8_SCHED;
            PG8_LDB(B0, 1, 0); PG8_LDB(B1, 1, 1); PG8_SCHED; PG8_LDA(At, 1, 0); PG8_STAGE(PG8_SA(0, 1), a2 + hstepA, voffA);
            PG8_WAIT_V(8); PG8_WAIT_L(0); PG8_BAR; PG8_MMA(0, 0, At, B0); PG8_MMA(0, 1, At, B1); PG8_BAR; PG8_SCHED;
            PG8_LDA(At, 1, 1); PG8_STAGE(PG8_SB(1, 0), b3, voffB); PG8_STAGE(PG8_SB(1, 1), b3 + hstepB, voffB); PG8_STAGE(PG8_SA(1, 0), a3, voffA);
            PG8_WAIT_V(8); PG8_WAIT_L(0); PG8_BAR; PG8_MMA(1, 0, At, B0); PG8_MMA(1, 1, At, B1); PG8_BAR; PG8_SCHED;
            } else {
            PG8_LDB(B0, 0, 0); PG8_SCHED; PG8_LDA(At, 0, 0); PG8_STAGE(PG8_SA(1, 1), a1 + hstepA, voffA);
            PG8_WAIT_L(8); PG8_BAR; PG8_WAIT_L(0); PG8_MMA(0, 0, At, B0); PG8_BAR; PG8_SCHED;
            PG8_LDB(B1, 0, 1); PG8_STAGE(PG8_SB(0, 0), b2, voffB);
            PG8_BAR; PG8_WAIT_L(0); PG8_MMA(0, 1, At, B1); PG8_BAR;
            PG8_LDA(At, 0, 1); PG8_STAGE(PG8_SA(0, 0), a2, voffA);
            PG8_BAR; PG8_WAIT_L(0); PG8_MMA(1, 0, At, B0); PG8_BAR; PG8_SCHED;
            PG8_STAGE(PG8_SB(0, 1), b2 + hstepB, voffB);
            PG8_WAIT_V(6); PG8_BAR; PG8_MMA(1, 1, At, B1); PG8_BAR;
            PG8_LDB(B0, 1, 0); PG8_SCHED; PG8_LDA(At, 1, 0); PG8_STAGE(PG8_SA(0, 1), a2 + hstepA, voffA);
            PG8_WAIT_L(8); PG8_BAR; PG8_WAIT_L(0); PG8_MMA(0, 0, At, B0); PG8_BAR; PG8_SCHED;
            PG8_LDB(B1, 1, 1); PG8_STAGE(PG8_SB(1, 0), b3, voffB);
            PG8_BAR; PG8_WAIT_L(0); PG8_MMA(0, 1, At, B1); PG8_BAR;
            PG8_LDA(At, 1, 1); PG8_STAGE(PG8_SA(1, 0), a3, voffA);
            PG8_BAR; PG8_WAIT_L(0); PG8_MMA(1, 0, At, B0); PG8_BAR; PG8_SCHED;
            PG8_STAGE(PG8_SB(1, 1), b3 + hstepB, voffB);
            PG8_WAIT_V(6); PG8_BAR; PG8_MMA(1, 1, At, B1); PG8_BAR;
            }
        }
        if constexpr (ALIGN_EPI) { if (wr == 0) PG8_BAR; }
        if constexpr (!Epi::AFTER_DRAIN) { E(acc, cur, wr, wc, fr, fq); S.done(cur); }
        if (!has_next) break;
#pragma unroll
        for (int a = 0; a < 2; ++a)
#pragma unroll
            for (int b = 0; b < 2; ++b)
#pragma unroll
                for (int m = 0; m < 4; ++m)
#pragma unroll
                    for (int n = 0; n < 2; ++n) acc[a][b][m][n] = (f32x4){0.f, 0.f, 0.f, 0.f};
        cur = nxt; cA = nA; cB = nB; ++ui;
        if constexpr (ALIGN_EPI) { if (wr == 1) PG8_BAR; }
    }
    PG8_WAIT_V(0);
    if constexpr (!ALIGN_EPI) { if (wr == 0) PG8_BAR; }
    PG8_BAR;
    if constexpr (Epi::AFTER_DRAIN) { E.fused(acc, cur, wr, wc, fr, fq, lds, wid, lane); S.done(cur); }
#undef PG8_SA
#undef PG8_SB
#undef PG8_STAGE
#undef PG8_LDA
#undef PG8_LDB
#undef PG8_MMA
#undef PG8_WAIT_V
#undef PG8_WAIT_L
#undef PG8_BAR
#undef PG8_SCHED
}
}
#ifndef PG8_SP2
#define PG8_SP2 true
#endif
#ifndef PG8_ALIGN
#define PG8_ALIGN true
#endif

constexpr int NWAVES = 8, NTHR = 512;
constexpr int D = 2048, BATCH = 4, SEQ = 4096, CTX = 256, GRIDW = 64;
constexpr int M_LAT = BATCH * SEQ;
constexpr int M_CTX = BATCH * CTX;
constexpr int M_ALL = M_LAT + M_CTX;
constexpr int MIXA = 1024, MIXB = 1024, SGU_G = 4, SGU_P = 128, SGU_GW = 256;
constexpr int GH = 4, GDK = 128, GDV = 256, GKDIM = 512, GLR = 16;
constexpr int N_IN = 5152, N_INP = 5376;
constexpr int C_U = 0, C_VS = 1024, C_Q = 2048, C_K = 2560, C_V = 3072, C_R = 4096, C_LRF = 5120, C_LRB = 5136;
constexpr int DFF = 5632, NUP = 2 * DFF;
constexpr int NMOD = 6, MODW = NMOD * D;
constexpr float EPS = 1e-6f;
constexpr int KSPLIT = 32;

constexpr size_t MiB = 1u << 20;
constexpr size_t WS_CTL = 0, CTL_ZERO_BYTES = 1 * MiB;
constexpr size_t WS_WUP = 1 * MiB;
constexpr size_t WS_WDN = 45 * MiB;
constexpr size_t WS_MOD = 67 * MiB;
constexpr size_t WS_RA  = 68 * MiB;
constexpr size_t WS_RU  = 136 * MiB;
constexpr size_t WS_WIN  = 136 * MiB;
constexpr size_t WS_WOUT = 157 * MiB;
constexpr size_t WS_MODP = 165 * MiB;
constexpr size_t WS_P    = 173 * MiB;
constexpr size_t WS_G    = 352 * MiB;
constexpr size_t WS_VP   = 420 * MiB;
constexpr size_t WS_END  = 488 * MiB;
static_assert(WS_P + (size_t)M_ALL * N_INP * 2 <= WS_G && WS_RU + (size_t)M_LAT * NUP * 2 <= WS_END, "ws map");

constexpr int LDS_BYTES = 147456;
constexpr int MISC_OFF = 131072 + 320;

#define GAS __attribute__((address_space(1)))
#define LAS __attribute__((address_space(3)))
typedef unsigned short bf16;
typedef unsigned v4u __attribute__((ext_vector_type(4)));
typedef unsigned v2u __attribute__((ext_vector_type(2)));
typedef float f32x4 __attribute__((ext_vector_type(4)));
#define LDS_WAIT() asm volatile("s_waitcnt lgkmcnt(0)" ::: "memory")
#define VM_WAIT() asm volatile("s_waitcnt vmcnt(0)" ::: "memory")
__device__ __forceinline__ unsigned f2bf(float f) { unsigned u = __builtin_bit_cast(unsigned, f); return (u + 0x7fffu + ((u >> 16) & 1u)) >> 16; }
__device__ __forceinline__ unsigned pk2(float lo, float hi) { return f2bf(lo) | (f2bf(hi) << 16); }
__device__ __forceinline__ float bf2f(unsigned h) { return __builtin_bit_cast(float, h << 16); }
__device__ __forceinline__ float bflo(unsigned w) { return __builtin_bit_cast(float, w << 16); }
__device__ __forceinline__ float bfhi(unsigned w) { return __builtin_bit_cast(float, w & 0xffff0000u); }
__device__ __forceinline__ float gelu_t(float x) { const float u = 1.5957691216f * (x + 0.044715f * x * x * x); return x / (1.0f + __expf(-u)); }
__device__ __forceinline__ float silu_f(float x) { return x / (1.0f + __expf(-x)); }
__device__ __forceinline__ float wave_sum(float v) {
#pragma unroll
    for (int o = 1; o < 64; o <<= 1) v += __shfl_xor(v, o);
    return v;
}

struct Args {
    const float *x, *c, *ctx, *c_ctx, *ada_w, *ada_b, *pre_mix_g, *post_mix_g, *pre_ffn_g, *post_ffn_g, *w_in, *sgu_ln_g, *sgu_ln_b, *sgu_w, *sgu_b,
                *gate_w_f, *gate_b_f, *gate_w_b, *gate_b_b, *gla_norm_g, *w_out, *w_up, *conv_w, *conv_b, *w_down;
    float* out; unsigned char* ws; int ph_lo, ph_hi;
};
struct Ctx {
    LAS unsigned char* lds; int tid, lane, wave, G, bx;
};

__device__ __forceinline__ void p0_transpose_item(const float* W, int K, int N, bf16* WT, LAS float* scr, int item, int lane) {
    const int nblk = N / 32, kb = item / nblk, nb = item % nblk, k0 = 64 * kb, n0 = 32 * nb;
#pragma unroll 8
    for (int i = 0; i < 32; ++i) { const int kk = 2 * i + (lane >> 5); scr[kk * 33 + (lane & 31)] = W[(size_t)(k0 + kk) * N + n0 + (lane & 31)]; }
    LDS_WAIT(); asm volatile("" ::: "memory");
    const int c = lane & 7;
#pragma unroll
    for (int j = 0; j < 4; ++j) { const int n = (lane >> 3) + 8 * j; const LAS float* s = scr + (8 * c) * 33 + n;
        v4u o; o.x = pk2(s[0 * 33], s[1 * 33]); o.y = pk2(s[2 * 33], s[3 * 33]); o.z = pk2(s[4 * 33], s[5 * 33]); o.w = pk2(s[6 * 33], s[7 * 33]);
        *(GAS v4u*)(WT + (size_t)(n0 + n) * K + k0 + 8 * c) = o; }
    LDS_WAIT(); asm volatile("" ::: "memory");
}

__device__ __forceinline__ void ph_prologue(const Args& a, const Ctx& c) {
    unsigned char* ws = a.ws;
    LAS float* scr = (LAS float*)(c.lds + c.wave * 16384);
    const int gw = c.bx * NWAVES + c.wave, NGW = c.G * NWAVES;
    constexpr int I_IN = (D / 64) * (N_IN / 32), I_OUT = (D / 64) * (D / 32), I_UP = (D / 64) * (NUP / 32), I_DN = (DFF / 64) * (D / 32);
    constexpr int NITEMS = I_IN + I_OUT + I_UP + I_DN;
    for (int it = gw; it < NITEMS; it += NGW) {
        int r = it;
        if (r < I_IN) { p0_transpose_item(a.w_in, D, N_IN, (bf16*)(ws + WS_WIN), scr, r, c.lane); continue; } r -= I_IN;
        if (r < I_OUT) { p0_transpose_item(a.w_out, D, D, (bf16*)(ws + WS_WOUT), scr, r, c.lane); continue; } r -= I_OUT;
        if (r < I_UP) { p0_transpose_item(a.w_up, D, NUP, (bf16*)(ws + WS_WUP), scr, r, c.lane); continue; } r -= I_UP;
        p0_transpose_item(a.w_down, DFF, D, (bf16*)(ws + WS_WDN), scr, r, c.lane);
    }
    { GAS v4u* z = (GAS v4u*)(ws + WS_WIN + (size_t)N_IN * D * 2); const int n16 = (N_INP - N_IN) * D * 2 / 16;
      for (int i = c.bx * NTHR + c.tid; i < n16; i += c.G * NTHR) z[i] = (v4u){0u, 0u, 0u, 0u}; }
    { float* modp = (float*)(ws + WS_MODP);
      for (int it = c.bx; it < KSPLIT * (MODW / NTHR); it += c.G) {
          const int kb = it / (MODW / NTHR), jb = it % (MODW / NTHR), j = jb * NTHR + c.tid;
          float acc[5] = {0.f, 0.f, 0.f, 0.f, 0.f};
          for (int k = kb * 64; k < kb * 64 + 64; ++k) {
              const float w = a.ada_w[(size_t)k * MODW + j];
#pragma unroll
              for (int r = 0; r < 5; ++r) { const float cv = (r < 4) ? a.c[r * D + k] : a.c_ctx[k]; acc[r] += silu_f(cv) * w; }
          }
#pragma unroll
          for (int r = 0; r < 5; ++r) modp[((size_t)kb * 5 + r) * MODW + j] = acc[r];
      } }
}

__device__ __forceinline__ void ph_modreduce(const Args& a, const Ctx& c) {
    const float* modp = (const float*)(a.ws + WS_MODP); float* mod = (float*)(a.ws + WS_MOD);
    for (int i = c.bx * NTHR + c.tid; i < 5 * MODW; i += c.G * NTHR) {
        const int j = i % MODW; float s = a.ada_b[j];
        for (int kb = 0; kb < KSPLIT; ++kb) s += modp[(size_t)kb * 5 * MODW + i];
        mod[i] = s;
    }
}

__device__ __forceinline__ void ph_prenorm(const Args& a, const Ctx& c) {
    const float* mod = (const float*)(a.ws + WS_MOD); bf16* A1 = (bf16*)(a.ws + WS_RA);
    const int gw = c.bx * NWAVES + c.wave, NGW = c.G * NWAVES;
    for (int m = gw; m < M_ALL; m += NGW) {
        const float* xr; int mr;
        if (m < M_LAT) { xr = a.x + (size_t)m * D; mr = m / SEQ; } else { xr = a.ctx + (size_t)(m - M_LAT) * D; mr = 4; }
        const float* sh = mod + (size_t)mr * MODW; const float* sc = sh + D;
        f32x4 v[8]; float s = 0.f;
#pragma unroll
        for (int j = 0; j < 8; ++j) { v[j] = *(const f32x4*)(xr + 4 * c.lane + 256 * j); s += (v[j].x * v[j].x + v[j].y * v[j].y) + (v[j].z * v[j].z + v[j].w * v[j].w); }
        const float rstd = 1.0f / sqrtf(wave_sum(s) * (1.0f / D) + EPS);
#pragma unroll
        for (int j = 0; j < 8; ++j) { const int col = 4 * c.lane + 256 * j;
            const f32x4 g = *(const f32x4*)(a.pre_mix_g + col), s1 = *(const f32x4*)(sc + col), s0 = *(const f32x4*)(sh + col);
            const f32x4 o = v[j] * rstd * g * (1.0f + s1) + s0;
            v2u w; w.x = pk2(o.x, o.y); w.y = pk2(o.z, o.w); *(v2u*)(A1 + (size_t)m * D + col) = w; }
    }
}

__device__ __forceinline__ float logsigmoid_f(float z) { return fminf(z, 0.f) - log1pf(expf(-fabsf(z))); }

__device__ __forceinline__ void ph_gates_vp(const Args& a, const Ctx& c) {
    const bf16* P = (const bf16*)(a.ws + WS_P); float* Gt = (float*)(a.ws + WS_G); bf16* VP = (bf16*)(a.ws + WS_VP);
    for (int it = c.bx; it < 2 * M_ALL; it += c.G) {
        const int row = it >> 1, dir = it & 1; const float* W = dir ? a.gate_w_b : a.gate_w_f; const float* Bv = dir ? a.gate_b_b : a.gate_b_f;
        float z = Bv[c.tid];
#pragma unroll
        for (int j = 0; j < GLR; ++j) z += bf2f(P[(size_t)row * N_INP + C_LRF + dir * GLR + j]) * W[j * GKDIM + c.tid];
        Gt[((size_t)dir * M_ALL + row) * GKDIM + c.tid] = logsigmoid_f(z) * (1.0f / 16.0f);
    }
    const int gw = c.bx * NWAVES + c.wave, NGW = c.G * NWAVES;
    for (int it = gw; it < M_LAT * SGU_G; it += NGW) {
        const int row = it >> 2, g = it & 3; const int col = g * SGU_GW + 4 * c.lane;
        const v2u w = *(const v2u*)(P + (size_t)row * N_INP + C_VS + col);
        float v0 = gelu_t(bflo(w.x)), v1 = gelu_t(bfhi(w.x)), v2 = gelu_t(bflo(w.y)), v3 = gelu_t(bfhi(w.y));
        const float mu = wave_sum((v0 + v1) + (v2 + v3)) * (1.0f / SGU_GW);
        v0 -= mu; v1 -= mu; v2 -= mu; v3 -= mu;
        const float rstd = 1.0f / sqrtf(wave_sum((v0 * v0 + v1 * v1) + (v2 * v2 + v3 * v3)) * (1.0f / SGU_GW) + EPS);
        const f32x4 lg = *(const f32x4*)(a.sgu_ln_g + col), lb = *(const f32x4*)(a.sgu_ln_b + col);
        v2u o; o.x = pk2(v0 * rstd * lg.x + lb.x, v1 * rstd * lg.y + lb.y); o.y = pk2(v2 * rstd * lg.z + lb.z, v3 * rstd * lg.w + lb.w);
        *(v2u*)(VP + (size_t)row * MIXA + col) = o;
    }
}

__device__ __forceinline__ void ph_mix_naive(const Args& a, const Ctx& c) {
    const bf16* P = (const bf16*)(a.ws + WS_P); const float* Gt = (const float*)(a.ws + WS_G); const bf16* VP = (const bf16*)(a.ws + WS_VP);
    bf16* YC = (bf16*)(a.ws + WS_RA); float* O = a.out;
    for (int it = c.bx; it < M_LAT * 2; it += c.G) {
        const int row = it >> 1, g = 2 * (it & 1) + (c.tid >> 8), ch = g * SGU_GW + (c.tid & 255);
        const int b = row / SEQ, t = row % SEQ, n = t / SGU_P, p = t % SGU_P;
        const float* wr = a.sgu_w + ((size_t)g * SGU_P + p) * SGU_P; const bf16* vp = VP + ((size_t)b * SEQ + n * SGU_P) * MIXA + ch;
        float s = a.sgu_b[g * SGU_P + p];
        for (int q = 0; q < SGU_P; ++q) s += wr[q] * bf2f(vp[(size_t)q * MIXA]);
        const float u = gelu_t(bf2f(P[(size_t)row * N_INP + C_U + ch]));
        YC[(size_t)row * D + ch] = (bf16)f2bf(u * s);
    }
    if (c.bx < 16) {
        constexpr int TB = 16;
        const int half = c.tid >> 8, v = c.tid & 255, chain = c.bx * 2 + half, b = chain >> 3, h = (chain >> 1) & 3, dir = chain & 1;
        LAS float* st = (LAS float*)c.lds + half * (TB * 384);
        float S[GDK];
#pragma unroll
        for (int d = 0; d < GDK; ++d) S[d] = 0.f;
        for (int i0 = 0; i0 < CTX + SEQ; i0 += TB) {
            __syncthreads();
            for (int idx = v; idx < TB * 384; idx += 256) {
                const int tt = idx / 384, e = idx % 384, i = i0 + tt;
                const int row = (i < CTX) ? (M_LAT + b * CTX + (dir ? CTX - 1 - i : i)) : (b * SEQ + (dir ? SEQ - 1 - (i - CTX) : (i - CTX)));
                float val;
                if (e < 128) val = bf2f(P[(size_t)row * N_INP + C_Q + h * GDK + e]) * 0.08838834764831845f;
                else if (e < 256) val = bf2f(P[(size_t)row * N_INP + C_K + h * GDK + (e - 128)]);
                else val = expf(Gt[((size_t)dir * M_ALL + row) * GKDIM + h * GDK + (e - 256)]);
                st[idx] = val;
            }
            __syncthreads();
            for (int tt = 0; tt < TB; ++tt) {
                const int i = i0 + tt;
                const int row = (i < CTX) ? (M_LAT + b * CTX + (dir ? CTX - 1 - i : i)) : (b * SEQ + (dir ? SEQ - 1 - (i - CTX) : (i - CTX)));
                const float vv = bf2f(P[(size_t)row * N_INP + C_V + h * GDV + v]);
                const LAS float* q = st + tt * 384; float o = 0.f;
#pragma unroll
                for (int d = 0; d < GDK; ++d) { S[d] = q[256 + d] * S[d] + q[128 + d] * vv; o += q[d] * S[d]; }
                if (i >= CTX) O[((size_t)dir * M_LAT + row) * MIXB + h * GDV + v] = o;
            }
        }
    }
}


typedef short bf16x8 __attribute__((ext_vector_type(8)));
typedef short s16x4 __attribute__((ext_vector_type(4)));
typedef LAS const unsigned char* ldsp;
__device__ __forceinline__ bf16x8 lds_row8(ldsp p) { return *(const LAS bf16x8*)p; }
__device__ __forceinline__ bf16x8 lds_tr8(ldsp p, int pitch) {
    const s16x4 lo = __builtin_bit_cast(s16x4, __builtin_amdgcn_ds_read_tr16_b64_v4i16((LAS s16x4*)p));
    const s16x4 hi = __builtin_bit_cast(s16x4, __builtin_amdgcn_ds_read_tr16_b64_v4i16((LAS s16x4*)(p + 4 * pitch)));
    return __builtin_shufflevector(lo, hi, 0, 1, 2, 3, 4, 5, 6, 7);
}
#define MFMA16(a, b, c) __builtin_amdgcn_mfma_f32_16x16x32_bf16((a), (b), (c), 0, 0, 0)
constexpr int NCK = CTX / 64 + SEQ / 64;
constexpr size_t WS_QE = WS_G, WS_KE = WS_G + 34 * MiB;
constexpr size_t WS_DEC = WS_VP;
__device__ __forceinline__ float logsig_fast(float z) { return fminf(z, 0.f) - __logf(1.0f + __expf(-fabsf(z))); }

__device__ __forceinline__ void prep_item(const Args& a, const Ctx& c, int item) {
    const bf16* P = (const bf16*)(a.ws + WS_P);
    const int h = item & 3, ck = (item >> 2) % NCK, b = (item >> 2) / NCK;
    const int r0 = ck < 4 ? (M_LAT + b * CTX + 64 * ck) : (b * SEQ + 64 * (ck - 4));
    LAS float* lrs = (LAS float*)c.lds;
    LAS float* tot = lrs + 64 * 32;
    const int dir = c.tid >> 8, half = (c.tid >> 7) & 1, d = c.tid & 127;
    { const int row = c.tid >> 3, c4 = (c.tid & 7) * 4; const v2u w = *(const v2u*)(P + (size_t)(r0 + row) * N_INP + C_LRF + c4);
      *(LAS f32x4*)(lrs + row * 32 + c4) = (f32x4){bflo(w.x), bfhi(w.x), bflo(w.y), bfhi(w.y)}; }
    const float* W = dir ? a.gate_w_b : a.gate_w_f; const float bias = (dir ? a.gate_b_b : a.gate_b_f)[h * GDK + d];
    float w[GLR];
#pragma unroll
    for (int j = 0; j < GLR; ++j) w[j] = W[j * GKDIM + h * GDK + d];
    __syncthreads();
    float g[32];
#pragma unroll
    for (int tt = 0; tt < 32; ++tt) { const LAS float* lr = lrs + (half * 32 + tt) * 32 + dir * GLR; float z = bias;
#pragma unroll
        for (int j = 0; j < GLR; ++j) z += lr[j] * w[j];
        g[tt] = logsig_fast(z) * (1.0f / 16.0f); }
    float run = 0.f;
    if (dir == 0) {
#pragma unroll
        for (int tt = 0; tt < 32; ++tt) { run += g[tt]; g[tt] = run; }
    } else {
#pragma unroll
        for (int tt = 31; tt >= 0; --tt) { run += g[tt]; g[tt] = run; }
    }
    tot[(dir * 2 + half) * 128 + d] = run;
    __syncthreads();
    const float other = tot[(dir * 2 + (half ^ 1)) * 128 + d];
    const float add = (dir == 0) ? (half == 1 ? other : 0.f) : (half == 0 ? other : 0.f);
    if (half == 0) ((float*)(a.ws + WS_DEC))[((size_t)(dir * BATCH + b) * NCK + ck) * GKDIM + h * GDK + d] = __expf(run + other);
    bf16* QE = (bf16*)(a.ws + WS_QE) + (size_t)dir * M_ALL * GKDIM; bf16* KE = (bf16*)(a.ws + WS_KE) + (size_t)dir * M_ALL * GKDIM;
#pragma unroll
    for (int tt = 0; tt < 32; ++tt) { const int row = r0 + half * 32 + tt; const float bb = g[tt] + add;
        const float q = bf2f(P[(size_t)row * N_INP + C_Q + h * GDK + d]), k = bf2f(P[(size_t)row * N_INP + C_K + h * GDK + d]);
        QE[(size_t)row * GKDIM + h * GDK + d] = (bf16)f2bf(q * 0.08838834764831845f * __expf(bb));
        KE[(size_t)row * GKDIM + h * GDK + d] = (bf16)f2bf(k * __expf(-bb)); }
}

__device__ __forceinline__ void sgu_item(const Args& a, const Ctx& c, int item) {
    constexpr int WP = 272, VPP = 528;
    const bf16* P = (const bf16*)(a.ws + WS_P); bf16* YC = (bf16*)(a.ws + WS_RA);
    const int g = item & 3, n = (item >> 2) & 31, b = item >> 7, r0 = b * SEQ + n * SGU_P;
    LAS unsigned char* Wb = c.lds; LAS unsigned char* Vt = c.lds + 128 * WP;
    const float* Ws = a.sgu_w + (size_t)g * SGU_P * SGU_P;
#pragma unroll
    for (int i = 0; i < 8; ++i) { const int idx = c.tid + 512 * i, p = idx >> 5, c4 = (idx & 31) * 4; const f32x4 w = *(const f32x4*)(Ws + p * SGU_P + c4);
        v2u o; o.x = pk2(w.x, w.y); o.y = pk2(w.z, w.w); *(LAS v2u*)(Wb + p * WP + c4 * 2) = o; }
    const int col = g * SGU_GW + 4 * c.lane;
    const f32x4 lg = *(const f32x4*)(a.sgu_ln_g + col), lb = *(const f32x4*)(a.sgu_ln_b + col);
    for (int i = 0; i < 16; ++i) { const int q = c.wave * 16 + i;
        const v2u w = *(const v2u*)(P + (size_t)(r0 + q) * N_INP + C_VS + col);
        float v0 = gelu_t(bflo(w.x)), v1 = gelu_t(bfhi(w.x)), v2 = gelu_t(bflo(w.y)), v3 = gelu_t(bfhi(w.y));
        const float mu = wave_sum((v0 + v1) + (v2 + v3)) * (1.0f / SGU_GW);
        v0 -= mu; v1 -= mu; v2 -= mu; v3 -= mu;
        const float rstd = 1.0f / sqrtf(wave_sum((v0 * v0 + v1 * v1) + (v2 * v2 + v3 * v3)) * (1.0f / SGU_GW) + EPS);
        v2u o; o.x = pk2(v0 * rstd * lg.x + lb.x, v1 * rstd * lg.y + lb.y); o.y = pk2(v2 * rstd * lg.z + lb.z, v3 * rstd * lg.w + lb.w);
        *(LAS v2u*)(Vt + q * VPP + 8 * c.lane) = o; }
    __syncthreads();
    const int l15 = c.lane & 15, lg4 = c.lane >> 4, tq = l15 >> 2, tp = l15 & 3;
    bf16x8 wf[4];
#pragma unroll
    for (int kc = 0; kc < 4; ++kc) wf[kc] = lds_row8(Wb + (16 * c.wave + l15) * WP + (32 * kc + 8 * lg4) * 2);
    const int p = 16 * c.wave + l15, row = r0 + p; const float bs = a.sgu_b[g * SGU_P + p];
    for (int cj = 0; cj < 16; ++cj) {
        f32x4 acc = {0.f, 0.f, 0.f, 0.f};
#pragma unroll
        for (int kc = 0; kc < 4; ++kc) { const bf16x8 vf = lds_tr8(Vt + (32 * kc + 8 * lg4 + tq) * VPP + (16 * cj + 4 * tp) * 2, VPP); acc = MFMA16(vf, wf[kc], acc); }
        const int ch = g * SGU_GW + 16 * cj + 4 * lg4;
        const v2u uw = *(const v2u*)(P + (size_t)row * N_INP + C_U + ch);
        v2u o; o.x = pk2(gelu_t(bflo(uw.x)) * (acc[0] + bs), gelu_t(bfhi(uw.x)) * (acc[1] + bs)); o.y = pk2(gelu_t(bflo(uw.y)) * (acc[2] + bs), gelu_t(bfhi(uw.y)) * (acc[3] + bs));
        *(v2u*)(YC + (size_t)row * D + ch) = o;
    }
    __syncthreads();
}

__device__ __forceinline__ void ph_prep(const Args& a, const Ctx& c) {
    for (int it = c.bx; it < BATCH * NCK * GH; it += c.G) prep_item(a, c, it);
    __syncthreads();
    for (int it = c.bx; it < BATCH * 32 * SGU_G; it += c.G) sgu_item(a, c, it);
}

__device__ __forceinline__ void ph_chains(const Args& a, const Ctx& c) {
    constexpr int QP = 272, VP = 80, AP = 144, SP = 272;
    constexpr int OFF_Q = 0, OFF_K = 64 * QP, OFF_V = 2 * 64 * QP, BUF = 2 * 64 * QP + 64 * VP;
    constexpr int OFF_ATT = 2 * BUF, OFF_ST = OFF_ATT + 64 * AP, ST_BYTES = 32 * SP;
    const bf16* P = (const bf16*)(a.ws + WS_P); float* O = a.out;
    const int l15 = c.lane & 15, lg4 = c.lane >> 4, tq = l15 >> 2, tp = l15 & 3, w = c.wave;
    for (int unit = ((c.G % 8 == 0) ? (c.bx % 8) * (c.G / 8) + c.bx / 8 : c.bx); unit < 256; unit += c.G) {
        const int dvs = unit & 7, chain = unit >> 3, b = chain >> 3, h = (chain >> 1) & 3, dir = chain & 1;
        const bf16* QEg = (const bf16*)(a.ws + WS_QE) + (size_t)dir * M_ALL * GKDIM + h * GDK;
        const bf16* KEg = (const bf16*)(a.ws + WS_KE) + (size_t)dir * M_ALL * GKDIM + h * GDK;
        const bf16* Vg = P + C_V + h * GDV + dvs * 32;
        const float* DECg = (const float*)(a.ws + WS_DEC) + (size_t)(dir * BATCH + b) * NCK * GKDIM + h * GDK + 16 * w + 4 * lg4;
        float* Og = O + (size_t)dir * M_LAT * MIXB + h * GDV + dvs * 32;
        auto chunk_of = [&](int i) { return i < 4 ? (dir ? 3 - i : i) : 4 + (dir ? 63 - (i - 4) : (i - 4)); };
        auto row0_of = [&](int ck) { return ck < 4 ? (M_LAT + b * CTX + 64 * ck) : (b * SEQ + 64 * (ck - 4)); };
        v4u rq[2], rk[2], rv;
        auto gload = [&](int ck) { const int r0 = row0_of(ck);
#pragma unroll
            for (int i = 0; i < 2; ++i) { const int idx = c.tid + 512 * i, r = idx >> 4, ch = idx & 15;
                rq[i] = *(const v4u*)(QEg + (size_t)(r0 + r) * GKDIM + ch * 8); rk[i] = *(const v4u*)(KEg + (size_t)(r0 + r) * GKDIM + ch * 8); }
            if (c.tid < 256) rv = *(const v4u*)(Vg + (size_t)(r0 + (c.tid >> 2)) * N_INP + (c.tid & 3) * 8); };
        auto lstore = [&](int buf) { LAS unsigned char* B = c.lds + buf * BUF;
#pragma unroll
            for (int i = 0; i < 2; ++i) { const int idx = c.tid + 512 * i, r = idx >> 4, ch = idx & 15;
                *(LAS v4u*)(B + OFF_Q + r * QP + ch * 16) = rq[i]; *(LAS v4u*)(B + OFF_K + r * QP + ch * 16) = rk[i]; }
            if (c.tid < 256) *(LAS v4u*)(B + OFF_V + (c.tid >> 2) * VP + (c.tid & 3) * 16) = rv; };
        __syncthreads();
        gload(chunk_of(0)); lstore(0);
        for (int i = c.tid; i < 2 * ST_BYTES / 4; i += NTHR) ((LAS unsigned*)(c.lds + OFF_ST))[i] = 0u;
        f32x4 Sacc[2] = {{0.f, 0.f, 0.f, 0.f}, {0.f, 0.f, 0.f, 0.f}};
        __syncthreads();
        for (int i = 0; i < NCK; ++i) {
            const int ck = chunk_of(i), cur = i & 1; ldsp B = c.lds + cur * BUF; LAS unsigned char* ATT = c.lds + OFF_ATT;
            ldsp STc = c.lds + OFF_ST + cur * ST_BYTES; LAS unsigned char* STn = c.lds + OFF_ST + (cur ^ 1) * ST_BYTES;
            if (i + 1 < NCK) gload(chunk_of(i + 1));
            const f32x4 dec = *(const f32x4*)(DECg + (size_t)ck * GKDIM);
            if (ck >= 4) {
                const int ti = w >> 1;
                bf16x8 qf[4];
#pragma unroll
                for (int kc = 0; kc < 4; ++kc) qf[kc] = lds_row8(B + OFF_Q + (16 * ti + l15) * QP + (32 * kc + 8 * lg4) * 2);
#pragma unroll
                for (int jj = 0; jj < 2; ++jj) { const int sj = 2 * (w & 1) + jj; f32x4 acc = {0.f, 0.f, 0.f, 0.f};
#pragma unroll
                    for (int kc = 0; kc < 4; ++kc) acc = MFMA16(lds_row8(B + OFF_K + (16 * sj + l15) * QP + (32 * kc + 8 * lg4) * 2), qf[kc], acc);
                    const int t = 16 * ti + l15, s0 = 16 * sj + 4 * lg4;
#pragma unroll
                    for (int r = 0; r < 4; ++r) { const bool keep = dir ? (s0 + r >= t) : (s0 + r <= t); if (!keep) acc[r] = 0.f; }
                    v2u o; o.x = pk2(acc[0], acc[1]); o.y = pk2(acc[2], acc[3]); *(LAS v2u*)(ATT + t * AP + s0 * 2) = o; }
                __syncthreads();
                const int vj = w & 1; f32x4 oacc = {0.f, 0.f, 0.f, 0.f};
#pragma unroll
                for (int kc = 0; kc < 2; ++kc) oacc = MFMA16(lds_tr8(B + OFF_V + (32 * kc + 8 * lg4 + tq) * VP + (16 * vj + 4 * tp) * 2, VP), lds_row8(ATT + (16 * ti + l15) * AP + (32 * kc + 8 * lg4) * 2), oacc);
#pragma unroll
                for (int kc = 0; kc < 4; ++kc) oacc = MFMA16(lds_row8(STc + (16 * vj + l15) * SP + (32 * kc + 8 * lg4) * 2), qf[kc], oacc);
                *(f32x4*)(Og + (size_t)(row0_of(ck) + 16 * ti + l15) * MIXB + 16 * vj + 4 * lg4) = oacc;
            }
#pragma unroll
            for (int kc = 0; kc < 2; ++kc) { const bf16x8 kf = lds_tr8(B + OFF_K + (32 * kc + 8 * lg4 + tq) * QP + (16 * w + 4 * tp) * 2, QP);
#pragma unroll
                for (int vj = 0; vj < 2; ++vj) Sacc[vj] = MFMA16(kf, lds_tr8(B + OFF_V + (32 * kc + 8 * lg4 + tq) * VP + (16 * vj + 4 * tp) * 2, VP), Sacc[vj]); }
#pragma unroll
            for (int vj = 0; vj < 2; ++vj) { Sacc[vj] = Sacc[vj] * dec;
                v2u o; o.x = pk2(Sacc[vj][0], Sacc[vj][1]); o.y = pk2(Sacc[vj][2], Sacc[vj][3]); *(LAS v2u*)(STn + (16 * vj + l15) * SP + (16 * w + 4 * lg4) * 2) = o; }
            if (i + 1 < NCK) lstore(cur ^ 1);
            __syncthreads();
        }
    }
}

__device__ __forceinline__ void ph_combine(const Args& a, const Ctx& c) {
    const bf16* P = (const bf16*)(a.ws + WS_P); bf16* YC = (bf16*)(a.ws + WS_RA); const float* O = a.out;
    const int gw = c.bx * NWAVES + c.wave, NGW = c.G * NWAVES;
    for (int it = gw; it < M_LAT * GH; it += NGW) {
        const int row = it >> 2, h = it & 3, col = h * GDV + 4 * c.lane;
        const f32x4 of = *(const f32x4*)(O + (size_t)row * MIXB + col), ob = *(const f32x4*)(O + ((size_t)M_LAT + row) * MIXB + col);
        const f32x4 o = of + ob;
        const float rstd = 1.0f / sqrtf(wave_sum((o.x * o.x + o.y * o.y) + (o.z * o.z + o.w * o.w)) * (1.0f / GDV) + EPS);
        const f32x4 ng = *(const f32x4*)(a.gla_norm_g + 4 * c.lane);
        const v2u rw = *(const v2u*)(P + (size_t)row * N_INP + C_R + col);
        v2u w; w.x = pk2(o.x * rstd * ng.x * silu_f(bflo(rw.x)), o.y * rstd * ng.y * silu_f(bfhi(rw.x)));
        w.y = pk2(o.z * rstd * ng.z * silu_f(bflo(rw.y)), o.w * rstd * ng.w * silu_f(bfhi(rw.y)));
        *(v2u*)(YC + (size_t)row * D + MIXA + col) = w;
    }
}

__device__ __forceinline__ void ph_mid(const Args& a, const Ctx& c) {
    const float* mod = (const float*)(a.ws + WS_MOD); const bf16* Y = (const bf16*)(a.ws + WS_P); bf16* Fo = (bf16*)(a.ws + WS_RA);
    const int gw = c.bx * NWAVES + c.wave, NGW = c.G * NWAVES;
    for (int m = gw; m < M_LAT; m += NGW) {
        const float* mr = mod + (size_t)(m / SEQ) * MODW; const float *gtm = mr + 2 * D, *shf = mr + 3 * D, *scf = mr + 4 * D;
        f32x4 y[8]; float s = 0.f;
#pragma unroll
        for (int j = 0; j < 8; ++j) { const v2u w = *(const v2u*)(Y + (size_t)m * D + 4 * c.lane + 256 * j); y[j] = (f32x4){bflo(w.x), bfhi(w.x), bflo(w.y), bfhi(w.y)};
            s += (y[j].x * y[j].x + y[j].y * y[j].y) + (y[j].z * y[j].z + y[j].w * y[j].w); }
        const float rstd = 1.0f / sqrtf(wave_sum(s) * (1.0f / D) + EPS); float s2 = 0.f;
#pragma unroll
        for (int j = 0; j < 8; ++j) { const int col = 4 * c.lane + 256 * j;
            const f32x4 xv = *(const f32x4*)(a.x + (size_t)m * D + col), g = *(const f32x4*)(a.post_mix_g + col), gt = *(const f32x4*)(gtm + col);
            y[j] = xv + gt * (y[j] * rstd * g); *(f32x4*)(a.out + (size_t)m * D + col) = y[j];
            s2 += (y[j].x * y[j].x + y[j].y * y[j].y) + (y[j].z * y[j].z + y[j].w * y[j].w); }
        const float rstd2 = 1.0f / sqrtf(wave_sum(s2) * (1.0f / D) + EPS);
#pragma unroll
        for (int j = 0; j < 8; ++j) { const int col = 4 * c.lane + 256 * j;
            const f32x4 g = *(const f32x4*)(a.pre_ffn_g + col), s1 = *(const f32x4*)(scf + col), s0 = *(const f32x4*)(shf + col);
            const f32x4 o = y[j] * rstd2 * g * (1.0f + s1) + s0;
            v2u w; w.x = pk2(o.x, o.y); w.y = pk2(o.z, o.w); *(v2u*)(Fo + (size_t)m * D + col) = w; }
    }
}

__device__ __forceinline__ void ph_conv(const Args& a, const Ctx& c) {
    bf16* U = (bf16*)(a.ws + WS_RU);
    constexpr int CH = DFF / 8;
    for (long idx = (long)c.bx * NTHR + c.tid; idx < (long)M_LAT * CH; idx += (long)c.G * NTHR) {
        const int m = (int)(idx / CH), ch = (int)(idx % CH) * 8, b = m / SEQ, t = m % SEQ, gi = t / GRIDW, gj = t % GRIDW;
        float acc[8];
        { const f32x4 b0 = *(const f32x4*)(a.conv_b + ch), b1 = *(const f32x4*)(a.conv_b + ch + 4);
          acc[0] = b0.x; acc[1] = b0.y; acc[2] = b0.z; acc[3] = b0.w; acc[4] = b1.x; acc[5] = b1.y; acc[6] = b1.z; acc[7] = b1.w; }
#pragma unroll
        for (int di = 0; di < 3; ++di)
#pragma unroll
            for (int dj = 0; dj < 3; ++dj) {
                const int ii = gi + di - 1, jj = gj + dj - 1;
                if (ii < 0 || ii >= GRIDW || jj < 0 || jj >= GRIDW) continue;
                const v4u w = *(const v4u*)(U + ((size_t)b * SEQ + ii * GRIDW + jj) * NUP + ch);
                const f32x4 k0 = *(const f32x4*)(a.conv_w + (size_t)(di * 3 + dj) * DFF + ch), k1 = *(const f32x4*)(a.conv_w + (size_t)(di * 3 + dj) * DFF + ch + 4);
                acc[0] += bflo(w.x) * k0.x; acc[1] += bfhi(w.x) * k0.y; acc[2] += bflo(w.y) * k0.z; acc[3] += bfhi(w.y) * k0.w;
                acc[4] += bflo(w.z) * k1.x; acc[5] += bfhi(w.z) * k1.y; acc[6] += bflo(w.w) * k1.z; acc[7] += bfhi(w.w) * k1.w;
            }
        const v4u vw = *(const v4u*)(U + (size_t)m * NUP + DFF + ch);
        v4u o; o.x = pk2(gelu_t(acc[0]) * bflo(vw.x), gelu_t(acc[1]) * bfhi(vw.x)); o.y = pk2(gelu_t(acc[2]) * bflo(vw.y), gelu_t(acc[3]) * bfhi(vw.y));
        o.z = pk2(gelu_t(acc[4]) * bflo(vw.z), gelu_t(acc[5]) * bfhi(vw.z)); o.w = pk2(gelu_t(acc[6]) * bflo(vw.w), gelu_t(acc[7]) * bfhi(vw.w));
        *(v4u*)(U + (size_t)m * NUP + DFF + ch) = o;
    }
}

__device__ __forceinline__ void ph_final(const Args& a, const Ctx& c) {
    const float* mod = (const float*)(a.ws + WS_MOD); const bf16* Z = (const bf16*)(a.ws + WS_RA);
    const int gw = c.bx * NWAVES + c.wave, NGW = c.G * NWAVES;
    for (int m = gw; m < M_LAT; m += NGW) {
        const float* gtf = mod + (size_t)(m / SEQ) * MODW + 5 * D;
        f32x4 z[8]; float s = 0.f;
#pragma unroll
        for (int j = 0; j < 8; ++j) { const v2u w = *(const v2u*)(Z + (size_t)m * D + 4 * c.lane + 256 * j); z[j] = (f32x4){bflo(w.x), bfhi(w.x), bflo(w.y), bfhi(w.y)};
            s += (z[j].x * z[j].x + z[j].y * z[j].y) + (z[j].z * z[j].z + z[j].w * z[j].w); }
        const float rstd = 1.0f / sqrtf(wave_sum(s) * (1.0f / D) + EPS);
#pragma unroll
        for (int j = 0; j < 8; ++j) { const int col = 4 * c.lane + 256 * j;
            const f32x4 hv = *(const f32x4*)(a.out + (size_t)m * D + col), g = *(const f32x4*)(a.post_ffn_g + col), gt = *(const f32x4*)(gtf + col);
            *(f32x4*)(a.out + (size_t)m * D + col) = hv + gt * (z[j] * rstd * g); }
    }
}

constexpr int N_PHASES = 13;
__global__ void __launch_bounds__(NTHR, 2) mk_fwd(Args a) {
    extern __shared__ __attribute__((aligned(16))) unsigned char lds_raw[];
    Ctx c; c.lds = (LAS unsigned char*)lds_raw; c.tid = threadIdx.x; c.lane = c.tid & 63; c.wave = __builtin_amdgcn_readfirstlane(c.tid >> 6); c.G = gridDim.x; c.bx = blockIdx.x;
    const int lo = a.ph_lo, hi = a.ph_hi;
#define IN(k) (lo <= (k) && (k) < hi)
#define SEAM(k) do { if (IN(k) && IN((k) + 1)) { cg::this_grid().sync(); } } while (0)
    typedef pg8::EpiBf16<0> EpiB;
    if (IN(0)) { ph_prologue(a, c); } SEAM(0);
    if (IN(1)) { ph_modreduce(a, c); } SEAM(1);
    if (IN(2)) { ph_prenorm(a, c); } SEAM(2);
    if (IN(3)) {
        pg8::Gemm g{(const bf16*)(a.ws + WS_RA), (const bf16*)(a.ws + WS_WIN), M_ALL, N_INP, D, D}; pg8::StaticOrder S; S.init(M_ALL, N_INP, c.G, c.bx);
        EpiB E{(bf16*)(a.ws + WS_P), N_INP, nullptr, 0, 0, 1.f};
        pg8::gemm_phase<EpiB, pg8::StaticOrder, PG8_ALIGN, PG8_SP2>(c.lds, g, S, E);
    } SEAM(3);
#ifdef MIX_NAIVE
    if (IN(4)) { ph_gates_vp(a, c); } SEAM(4);
    if (IN(5)) { ph_mix_naive(a, c); } SEAM(5);
#else
    if (IN(4)) { ph_prep(a, c); } SEAM(4);
    if (IN(5)) { ph_chains(a, c); } SEAM(5);
#endif
    if (IN(6)) { ph_combine(a, c); } SEAM(6);
    if (IN(7)) {
        pg8::Gemm g{(const bf16*)(a.ws + WS_RA), (const bf16*)(a.ws + WS_WOUT), M_LAT, D, D, D}; pg8::StaticOrder S; S.init(M_LAT, D, c.G, c.bx);
        EpiB E{(bf16*)(a.ws + WS_P), D, nullptr, 0, 0, 1.f};
        pg8::gemm_phase<EpiB, pg8::StaticOrder, PG8_ALIGN, PG8_SP2>(c.lds, g, S, E);
    } SEAM(7);
    if (IN(8)) { ph_mid(a, c); } SEAM(8);
    if (IN(9)) {
        pg8::Gemm g{(const bf16*)(a.ws + WS_RA), (const bf16*)(a.ws + WS_WUP), M_LAT, NUP, D, D}; pg8::StaticOrder S; S.init(M_LAT, NUP, c.G, c.bx);
        EpiB E{(bf16*)(a.ws + WS_RU), NUP, nullptr, 0, 0, 1.f};
        pg8::gemm_phase<EpiB, pg8::StaticOrder, PG8_ALIGN, PG8_SP2>(c.lds, g, S, E);
    } SEAM(9);
    if (IN(10)) { ph_conv(a, c); } SEAM(10);
    if (IN(11)) {
        pg8::Gemm g{(const bf16*)(a.ws + WS_RU) + DFF, (const bf16*)(a.ws + WS_WDN), M_LAT, D, DFF, NUP}; pg8::StaticOrder S; S.init(M_LAT, D, c.G, c.bx);
        EpiB E{(bf16*)(a.ws + WS_RA), D, nullptr, 0, 0, 1.f};
        pg8::gemm_phase<EpiB, pg8::StaticOrder, PG8_ALIGN, PG8_SP2>(c.lds, g, S, E);
    } SEAM(11);
    if (IN(12)) { ph_final(a, c); }
#undef IN
#undef SEAM
}

#ifndef MK_ONE_LAUNCH
#define MK_ONE_LAUNCH 1
#endif
extern "C" void kernel_launch(void* const* d_in, const int* in_sizes, int n_in, void* d_out, int out_size, void* d_ws, size_t ws_size, hipStream_t stream) {
    static int grid = 0;
    if (grid == 0) {
        if (n_in != 25 || in_sizes[0] != M_LAT * D || out_size != M_LAT * D || ws_size < WS_END) { fprintf(stderr, "kernel_launch: unexpected shapes (n_in %d, ws %zu)\n", n_in, ws_size); grid = -1; return; }
        int dev = 0, cus = 0, per_cu = 0;
        (void)hipGetDevice(&dev); (void)hipDeviceGetAttribute(&cus, hipDeviceAttributeMultiprocessorCount, dev);
        (void)hipFuncSetAttribute((const void*)mk_fwd, hipFuncAttributeMaxDynamicSharedMemorySize, LDS_BYTES);
        (void)hipOccupancyMaxActiveBlocksPerMultiprocessor(&per_cu, (const void*)mk_fwd, NTHR, LDS_BYTES);
        (void)hipGetLastError();
        if (per_cu < 1) { fprintf(stderr, "kernel_launch: occupancy query says %d blocks per CU\n", per_cu); grid = -1; return; }
        grid = cus;
    }
    if (grid < 0) return;
    Args a{};
    const float** f = (const float**)&a;
    for (int i = 0; i < 25; ++i) f[i] = (const float*)d_in[i];
    a.out = (float*)d_out; a.ws = (unsigned char*)d_ws;
    (void)hipMemsetAsync((char*)d_ws + WS_CTL, 0, CTL_ZERO_BYTES, stream);
#if MK_ONE_LAUNCH
    a.ph_lo = 0; a.ph_hi = N_PHASES;
    void* args[] = {&a};
    hipError_t e = hipLaunchCooperativeKernel((const void*)mk_fwd, dim3(grid), dim3(NTHR), args, LDS_BYTES, stream);
    if (e != hipSuccess) fprintf(stderr, "cooperative launch failed: %s (grid %d)\n", hipGetErrorString(e), grid);
#else
    for (int p = 0; p < N_PHASES; ++p) { a.ph_lo = p; a.ph_hi = p + 1; hipLaunchKernelGGL(mk_fwd, dim3(grid), dim3(NTHR), LDS_BYTES, stream, a); }
#endif
}
```

```cpp
#include <hip/hip_runtime.h>
#include <hip/hip_cooperative_groups.h>
#include <cstdio>
#include <cstdint>
namespace cg = cooperative_groups;
namespace pg8 {
#define PG8_LAS __attribute__((address_space(3)))
typedef unsigned short bf16_t;
typedef short bf16x8 __attribute__((ext_vector_type(8)));
typedef float f32x4 __attribute__((ext_vector_type(4)));
typedef unsigned u32x4 __attribute__((ext_vector_type(4)));
constexpr int BM = 256, BK = 64, HALF = 128, HTB = HALF * BK * 2  , STAGE_BYTES = 8 * HTB, NXCD = 8, WGM = 8;

__host__ __device__ __forceinline__ int lds_byte(int r, int c) { const int st = (r >> 4) * 2 + (c >> 5), rr = r & 15, cc = c & 31, ob = rr * 64 + cc * 2; return st * 1024 + (ob ^ (((ob >> 9) & 1) << 5)); }
__host__ __device__ __forceinline__ void stage_rc(int b, int& R, int& C) { const int st = b / 1024, sb = b % 1024, swz = sb ^ (((sb >> 9) & 1) << 5); R = (st >> 1) * 16 + swz / 64; C = (st & 1) * 32 + (swz % 64) / 2; }
__host__ __device__ __forceinline__ int perm32(int rho) { const int n = rho >> 4, i = rho & 15; return 8 * (i >> 2) + 4 * n + (i & 3); }

struct Unit { int pm, pn; };
struct Gemm { const bf16_t* A; const bf16_t* Bt; int M, N, K, lda; };

struct StaticOrder {
    int nM, nN, nwg, G, c;
    __host__ __device__ void init(int M, int N, int G_, int c_) { nM = M / BM; nN = N / BM; nwg = nM * nN; G = G_; c = c_; }
    __host__ __device__ bool next(int i, Unit& u) const {
        const long L = (long)i * G + c; if (L >= nwg) return false;
        int wgid = (int)L; { const int q = nwg / NXCD, r = nwg % NXCD, xcd = wgid % NXCD, off = wgid / NXCD; wgid = (xcd < r ? xcd * (q + 1) : r * (q + 1) + (xcd - r) * q) + off; }
        const int nig = WGM * nN, gid = wgid / nig, fm = gid * WGM, gsz = (nM - fm) < WGM ? (nM - fm) : WGM;
        u.pm = fm + ((wgid % nig) % gsz); u.pn = (wgid % nig) / gsz; return true;
    }
    __device__ __forceinline__ void a_ready(const Unit&) const {}
    __device__ __forceinline__ void done(const Unit&) const {}
};

__device__ __forceinline__ unsigned cvt_pk_bf16(float lo, float hi) { unsigned r; asm volatile("v_cvt_pk_bf16_f32 %0, %1, %2" : "=v"(r) : "v"(lo), "v"(hi)); return r; }
typedef float f32x2 __attribute__((ext_vector_type(2)));
__device__ __forceinline__ f32x2 gelu_pk(f32x2 v) {
    const f32x2 av = __builtin_elementwise_abs(v), d = av * 0.2316418882f + 1.0f;
    f32x2 t; t.x = __builtin_amdgcn_rcpf(d.x); t.y = __builtin_amdgcn_rcpf(d.y);
    f32x2 q = t * 0.5307027145f + (-0.7265760135f); q = q * t + 0.7107068705f; q = q * t + (-0.142248368f); q = q * t + 0.127414796f; q = q * t;
    const f32x2 s = (v * v) * (-0.72134752044f);
    f32x2 e; e.x = __builtin_amdgcn_exp2f(s.x); e.y = __builtin_amdgcn_exp2f(s.y);
    const f32x2 m = v * (q * e), r = v - m;
    f32x2 o; o.x = v.x < 0.f ? m.x : r.x; o.y = v.y < 0.f ? m.y : r.y; return o;
}

template <int ACT  > struct EpiBf16 {
    static constexpr bool PERM = true, AFTER_DRAIN = false; static_assert(ACT == 0 || ACT == 1, "EpiBf16: ACT is 0 (none) or 1 (gelu_pk)");
    bf16_t* O; int ldc; const float* bias; int split_cols; size_t split_stride; float scale0;
    __device__ __forceinline__ void operator()(const f32x4 (&acc)[2][2][4][2], const Unit& u, int wr, int wc, int fr, int fq) const {
        const int row0 = u.pm * BM + wr * 64 + fr; int colt = u.pn * BM; bf16_t* base = O;
        float sc = 1.f; if (split_cols) { const int t = colt / split_cols; base += (size_t)t * split_stride; colt -= t * split_cols; if (t == 0) sc = scale0; }
        const int col0 = colt + wc * 32 + 8 * fq, bcol0 = u.pn * BM + wc * 32 + 8 * fq;
        f32x4 bv[2][2];
#pragma unroll
        for (int bj = 0; bj < 2; ++bj)
#pragma unroll
            for (int n = 0; n < 2; ++n) bv[bj][n] = bias ? *(const f32x4*)(bias + bcol0 + bj * HALF + 4 * n) : (f32x4){0.f, 0.f, 0.f, 0.f};
#pragma unroll
        for (int ai = 0; ai < 2; ++ai)
#pragma unroll
            for (int m = 0; m < 4; ++m) { bf16_t* rowp = base + (size_t)(row0 + ai * HALF + m * 16) * ldc + col0;
#pragma unroll
                for (int bj = 0; bj < 2; ++bj) { f32x4 v0 = acc[ai][bj][m][0] + bv[bj][0], v1 = acc[ai][bj][m][1] + bv[bj][1];
                    if (ACT == 1) { f32x2 a = gelu_pk((f32x2){v0[0], v0[1]}), b = gelu_pk((f32x2){v0[2], v0[3]}), c = gelu_pk((f32x2){v1[0], v1[1]}), d = gelu_pk((f32x2){v1[2], v1[3]});
                        v0 = (f32x4){a.x, a.y, b.x, b.y}; v1 = (f32x4){c.x, c.y, d.x, d.y}; }
                    v0 = v0 * sc; v1 = v1 * sc; u32x4 w; w.x = cvt_pk_bf16(v0[0], v0[1]); w.y = cvt_pk_bf16(v0[2], v0[3]); w.z = cvt_pk_bf16(v1[0], v1[1]); w.w = cvt_pk_bf16(v1[2], v1[3]);
                    *(u32x4*)(rowp + bj * HALF) = w; } }
    }
};
template <class Epi, class Sched, bool ALIGN_EPI = false, bool SP2 = false>
__device__ __forceinline__ void gemm_phase(PG8_LAS unsigned char* lds, const Gemm g, const Sched& S, const Epi& E) {
    const int tid = threadIdx.x, wid = __builtin_amdgcn_readfirstlane(tid >> 6), lane = tid & 63, wr = wid >> 2, wc = wid & 3, fr = lane & 15, fq = lane >> 4;
    const int K = g.K, nt = K / BK, LDA = g.lda;
    unsigned voffA[2], voffB[2];
#pragma unroll
    for (int i = 0; i < 2; ++i) { int R, C; stage_rc(tid * 16 + i * 8192, R, C); const int Rb = Epi::PERM ? ((R & ~31) + perm32(R & 31)) : R;
        voffA[i] = (unsigned)(R * LDA + C) * 2u; voffB[i] = (unsigned)(Rb * K + C) * 2u; }
    const size_t kstep = (size_t)(BK * 2);
    const size_t hstepB = (size_t)HALF * K * 2, hstepA = (size_t)HALF * LDA * 2;
    const size_t tstepB = 2 * hstepB, tstepA = 2 * hstepA;
    const unsigned ldsw = (unsigned)wid * 1024u;
    const int aoff = lds_byte(wr * 64 + fr, fq * 8), boff = lds_byte(wc * 32 + fr, fq * 8);
#define PG8_SA(b, h) (((b) * 2 + (h)) * HTB)
#define PG8_SB(b, h) ((4 + (b) * 2 + (h)) * HTB)
#define PG8_STAGE(bufoff, gbase, voff) do { _Pragma("unroll") for (int _i = 0; _i < 2; ++_i) \
        __builtin_amdgcn_global_load_lds((const unsigned*)((const char*)(gbase) + (voff)[_i]), (PG8_LAS unsigned*)(lds + (bufoff) + ldsw + _i * 8192), 16, 0, 0); } while (0)
#define PG8_LDA(dst, b, h) do { _Pragma("unroll") for (int m = 0; m < 4; ++m) _Pragma("unroll") for (int k = 0; k < 2; ++k) dst[m][k] = *(const PG8_LAS bf16x8*)(lds + PG8_SA(b, h) + aoff + m * 2048 + k * 1024); } while (0)
#define PG8_LDB(dst, b, h) do { _Pragma("unroll") for (int n = 0; n < 2; ++n) _Pragma("unroll") for (int k = 0; k < 2; ++k) dst[n][k] = *(const PG8_LAS bf16x8*)(lds + PG8_SB(b, h) + boff + n * 2048 + k * 1024); } while (0)
#define PG8_MMA(ai, bj, At, Bt) do { __builtin_amdgcn_s_setprio(1); _Pragma("unroll") for (int m = 0; m < 4; ++m) _Pragma("unroll") for (int n = 0; n < 2; ++n) _Pragma("unroll") for (int k = 0; k < 2; ++k) \
        acc[ai][bj][m][n] = __builtin_amdgcn_mfma_f32_16x16x32_bf16(Bt[n][k], At[m][k], acc[ai][bj][m][n], 0, 0, 0); __builtin_amdgcn_s_setprio(0); } while (0)
#define PG8_WAIT_V(n) asm volatile("s_waitcnt vmcnt(" #n ")" ::: "memory")
#define PG8_WAIT_L(n) asm volatile("s_waitcnt lgkmcnt(" #n ")" ::: "memory")
#define PG8_BAR __builtin_amdgcn_s_barrier()
#define PG8_SCHED __builtin_amdgcn_sched_barrier(0)
    Unit cur, nxt; int ui = 0;
    if (!S.next(0, cur)) return;
    f32x4 acc[2][2][4][2];
#pragma unroll
    for (int a = 0; a < 2; ++a)
#pragma unroll
        for (int b = 0; b < 2; ++b)
#pragma unroll
            for (int m = 0; m < 4; ++m)
#pragma unroll
                for (int n = 0; n < 2; ++n) acc[a][b][m][n] = (f32x4){0.f, 0.f, 0.f, 0.f};
    bf16x8 At[4][2], B0[2][2], B1[2][2];
    const char* cA = (const char*)g.A + (size_t)cur.pm * tstepA; const char* cB = (const char*)g.Bt + (size_t)cur.pn * tstepB;
    S.a_ready(cur);
    if constexpr (SP2) {
        PG8_STAGE(PG8_SB(0, 0), cB, voffB); PG8_STAGE(PG8_SB(0, 1), cB + hstepB, voffB); PG8_STAGE(PG8_SA(0, 0), cA, voffA); PG8_STAGE(PG8_SA(0, 1), cA + hstepA, voffA);
        if (wr == 1) PG8_BAR;
        PG8_WAIT_V(2); PG8_BAR;
        PG8_STAGE(PG8_SB(1, 0), cB + kstep, voffB); PG8_STAGE(PG8_SA(1, 0), cA + kstep, voffA); PG8_STAGE(PG8_SB(1, 1), cB + hstepB + kstep, voffB);
        PG8_WAIT_V(6); PG8_BAR;
    } else {
        PG8_STAGE(PG8_SB(0, 0), cB, voffB); PG8_STAGE(PG8_SA(0, 0), cA, voffA); PG8_STAGE(PG8_SB(0, 1), cB + hstepB, voffB); PG8_STAGE(PG8_SA(0, 1), cA + hstepA, voffA);
        if (wr == 1) PG8_BAR;
        PG8_WAIT_V(4); PG8_BAR;
        PG8_STAGE(PG8_SB(1, 0), cB + kstep, voffB); PG8_STAGE(PG8_SA(1, 0), cA + kstep, voffA); PG8_STAGE(PG8_SB(1, 1), cB + hstepB + kstep, voffB);
        PG8_WAIT_V(6); PG8_BAR;
    }
    for (;;) {
        const bool has_next = S.next(ui + 1, nxt);
        const char* nA = has_next ? (const char*)g.A + (size_t)nxt.pm * tstepA : cA; const char* nB = has_next ? (const char*)g.Bt + (size_t)nxt.pn * tstepB : cB;
        for (int t = 0; t < nt; t += 2) {
            const bool last = (t == nt - 2);
            const char* a1 = cA + (size_t)(t + 1) * kstep;
            const char* a2 = last ? nA : cA + (size_t)(t + 2) * kstep; const char* b2 = last ? nB : cB + (size_t)(t + 2) * kstep;
            const char* a3 = a2 + kstep; const char* b3 = b2 + kstep;
            if (last && has_next) S.a_ready(nxt);
            if constexpr (SP2) {
            PG8_LDB(B0, 0, 0); PG8_LDB(B1, 0, 1); PG8_SCHED; PG8_LDA(At, 0, 0); PG8_STAGE(PG8_SA(1, 1), a1 + hstepA, voffA);
            PG8_WAIT_V(8); PG8_WAIT_L(0); PG8_BAR; PG8_MMA(0, 0, At, B0); PG8_MMA(0, 1, At, B1); PG8_BAR; PG8_SCHED;
            PG8_LDA(At, 0, 1); PG8_STAGE(PG8_SB(0, 0), b2, voffB); PG8_STAGE(PG8_SB(0, 1), b2 + hstepB, voffB); PG8_STAGE(PG8_SA(0, 0), a2, voffA);
            PG8_WAIT_V(8); PG8_WAIT_L(0); PG8_BAR; PG8_MMA(1, 0, At, B0); PG8_MMA(1, 1, At, B1); PG8_BAR; PG8_SCHED;
            PG8_LDB(B0, 1, 0); PG8_LDB(B1, 1, 1); PG8_SCHED; PG8_LDA(At, 1, 0); PG8_STAGE(PG8_SA(0, 1), a2 + hstepA, voffA);
            PG8_WAIT_V(8); PG8_WAIT_L(0); PG8_BAR; PG8_MMA(0, 0, At, B0); PG8_MMA(0, 1, At, B1); PG8_BAR; PG8_SCHED;
            PG8_LDA(At, 1, 1); PG8_STAGE(PG8_SB(1, 0), b3, voffB); PG8_STAGE(PG8_SB(1, 1), b3 + hstepB, voffB); PG8_STAGE(PG8_SA(1, 0), a3, voffA);
            PG8_WAIT_V(8); PG8_WAIT_L(0); PG8_BAR; PG8_MMA(1, 0, At, B0); PG8_MMA(1, 1, At, B1); PG8_BAR; PG8_SCHED;
            } else {
            PG8_LDB(B0, 0, 0); PG8_SCHED; PG8_LDA(At, 0, 0); PG8_STAGE(PG8_SA(1, 1), a1 + hstepA, voffA);
            PG8_WAIT_L(8); PG8_BAR; PG8_WAIT_L(0); PG8_MMA(0, 0, At, B0); PG8_BAR; PG8_SCHED;
            PG8_LDB(B1, 0, 1); PG8_STAGE(PG8_SB(0, 0), b2, voffB);
            PG8_BAR; PG8_WAIT_L(0); PG8_MMA(0, 1, At, B1); PG8_BAR;
            PG8_LDA(At, 0, 1); PG8_STAGE(PG8_SA(0, 0), a2, voffA);
            PG8_BAR; PG8_WAIT_L(0); PG8_MMA(1, 0, At, B0); PG8_BAR; PG8_SCHED;
            PG8_STAGE(PG8_SB(0, 1), b2 + hstepB, voffB);
            PG8_WAIT_V(6); PG8_BAR; PG8_MMA(1, 1, At, B1); PG8_BAR;
            PG8_LDB(B0, 1, 0); PG8_SCHED; PG8_LDA(At, 1, 0); PG8_STAGE(PG8_SA(0, 1), a2 + hstepA, voffA);
            PG8_WAIT_L(8); PG8_BAR; PG8_WAIT_L(0); PG8_MMA(0, 0, At, B0); PG8_BAR; PG8_SCHED;
            PG8_LDB(B1, 1, 1); PG8_STAGE(PG8_SB(1, 0), b3, voffB);
            PG8_BAR; PG8_WAIT_L(0); PG8_MMA(0, 1, At, B1); PG8_BAR;
            PG8_LDA(At, 1, 1); PG8_STAGE(PG8_SA(1, 0), a3, voffA);
            PG8_BAR; PG8_WAIT_L(0); PG8_MMA(1, 0, At, B0); PG8_BAR; PG8_SCHED;
            PG8_STAGE(PG8_SB(1, 1), b3 + hstepB, voffB);
            PG8_WAIT_V(6); PG8_BAR; PG8_MMA(1, 1, At, B1); PG8_BAR;
            }
        }
        if constexpr (ALIGN_EPI) { if (wr == 0) PG8_BAR; }
        if constexpr (!Epi::AFTER_DRAIN) { E(acc, cur, wr, wc, fr, fq); S.done(cur); }
        if (!has_next) break;
#pragma unroll
        for (int a = 0; a < 2; ++a)
#pragma unroll
            for (int b = 0; b < 2; ++b)
#pragma unroll
                for (int m = 0; m < 4; ++m)
#pragma unroll
                    for (int n = 0; n < 2; ++n) acc[a][b][m][n] = (f32x4){0.f, 0.f, 0.f, 0.f};
        cur = nxt; cA = nA; cB = nB; ++ui;
        if constexpr (ALIGN_EPI) { if (wr == 1) PG8_BAR; }
    }
    PG8_WAIT_V(0);
    if constexpr (!ALIGN_EPI) { if (wr == 0) PG8_BAR; }
    PG8_BAR;
    if constexpr (Epi::AFTER_DRAIN) { E.fused(acc, cur, wr, wc, fr, fq, lds, wid, lane); S.done(cur); }
#undef PG8_SA
#undef PG8_SB
#undef PG8_STAGE
#undef PG8_LDA
#undef PG8_LDB
#undef PG8_MMA
#undef PG8_WAIT_V
#undef PG8_WAIT_L
#undef PG8_BAR
#undef PG8_SCHED
}
}
#ifndef PG8_SP2
#define PG8_SP2 true
#endif
#ifndef PG8_ALIGN
#define PG8_ALIGN true
#endif

constexpr int NWAVES = 8, NTHR = 512;
constexpr int D = 2048, BATCH = 4, SEQ = 4096, CTX = 256, GRIDW = 64;
constexpr int M_LAT = BATCH * SEQ;
constexpr int M_CTX = BATCH * CTX;
constexpr int M_ALL = M_LAT + M_CTX;
constexpr int MIXA = 1024, MIXB = 1024, SGU_G = 4, SGU_P = 128, SGU_GW = 256;
constexpr int GH = 4, GDK = 128, GDV = 256, GKDIM = 512, GLR = 16;
constexpr int N_IN = 5152, N_INP = 5376;
constexpr int C_U = 0, C_VS = 1024, C_Q = 2048, C_K = 2560, C_V = 3072, C_R = 4096, C_LRF = 5120, C_LRB = 5136;
constexpr int DFF = 5632, NUP = 2 * DFF;
constexpr int NMOD = 6, MODW = NMOD * D;
constexpr float EPS = 1e-6f;
constexpr int KSPLIT = 32;

constexpr size_t MiB = 1u << 20;
constexpr size_t WS_CTL = 0, CTL_ZERO_BYTES = 1 * MiB;
constexpr size_t WS_WUP = 1 * MiB;
constexpr size_t WS_WDN = 45 * MiB;
constexpr size_t WS_MOD = 67 * MiB;
constexpr size_t WS_RA  = 68 * MiB;
constexpr size_t WS_RU  = 136 * MiB;
constexpr size_t WS_WIN  = 136 * MiB;
constexpr size_t WS_WOUT = 157 * MiB;
constexpr size_t WS_MODP = 165 * MiB;
constexpr size_t WS_P    = 173 * MiB;
constexpr size_t WS_G    = 352 * MiB;
constexpr size_t WS_VP   = 420 * MiB;
constexpr size_t WS_END  = 488 * MiB;
static_assert(WS_P + (size_t)M_ALL * N_INP * 2 <= WS_G && WS_RU + (size_t)M_LAT * NUP * 2 <= WS_END, "ws map");

constexpr int LDS_BYTES = 147456;
constexpr int MISC_OFF = 131072 + 320;

#define GAS __attribute__((address_space(1)))
#define LAS __attribute__((address_space(3)))
typedef unsigned short bf16;
typedef unsigned v4u __attribute__((ext_vector_type(4)));
typedef unsigned v2u __attribute__((ext_vector_type(2)));
typedef float f32x4 __attribute__((ext_vector_type(4)));
#define LDS_WAIT() asm volatile("s_waitcnt lgkmcnt(0)" ::: "memory")
#define VM_WAIT() asm volatile("s_waitcnt vmcnt(0)" ::: "memory")
__device__ __forceinline__ unsigned f2bf(float f) { unsigned u = __builtin_bit_cast(unsigned, f); return (u + 0x7fffu + ((u >> 16) & 1u)) >> 16; }
__device__ __forceinline__ unsigned pk2(float lo, float hi) { return f2bf(lo) | (f2bf(hi) << 16); }
__device__ __forceinline__ float bf2f(unsigned h) { return __builtin_bit_cast(float, h << 16); }
__device__ __forceinline__ float bflo(unsigned w) { return __builtin_bit_cast(float, w << 16); }
__device__ __forceinline__ float bfhi(unsigned w) { return __builtin_bit_cast(float, w & 0xffff0000u); }
__device__ __forceinline__ float gelu_t(float x) { const float u = 1.5957691216f * (x + 0.044715f * x * x * x); return x / (1.0f + __expf(-u)); }
__device__ __forceinline__ float silu_f(float x) { return x / (1.0f + __expf(-x)); }
__device__ __forceinline__ float wave_sum(float v) {
#pragma unroll
    for (int o = 1; o < 64; o <<= 1) v += __shfl_xor(v, o);
    return v;
}

struct Args {
    const float *x, *c, *ctx, *c_ctx, *ada_w, *ada_b, *pre_mix_g, *post_mix_g, *pre_ffn_g, *post_ffn_g, *w_in, *sgu_ln_g, *sgu_ln_b, *sgu_w, *sgu_b,
                *gate_w_f, *gate_b_f, *gate_w_b, *gate_b_b, *gla_norm_g, *w_out, *w_up, *conv_w, *conv_b, *w_down;
    float* out; unsigned char* ws; int ph_lo, ph_hi;
};
struct Ctx {
    LAS unsigned char* lds; int tid, lane, wave, G, bx;
};

__device__ __forceinline__ void p0_transpose_item(const float* W, int K, int N, bf16* WT, LAS float* scr, int item, int lane) {
    const int nblk = N / 32, kb = item / nblk, nb = item % nblk, k0 = 64 * kb, n0 = 32 * nb;
#pragma unroll 8
    for (int i = 0; i < 32; ++i) { const int kk = 2 * i + (lane >> 5); scr[kk * 33 + (lane & 31)] = W[(size_t)(k0 + kk) * N + n0 + (lane & 31)]; }
    LDS_WAIT(); asm volatile("" ::: "memory");
    const int c = lane & 7;
#pragma unroll
    for (int j = 0; j < 4; ++j) { const int n = (lane >> 3) + 8 * j; const LAS float* s = scr + (8 * c) * 33 + n;
        v4u o; o.x = pk2(s[0 * 33], s[1 * 33]); o.y = pk2(s[2 * 33], s[3 * 33]); o.z = pk2(s[4 * 33], s[5 * 33]); o.w = pk2(s[6 * 33], s[7 * 33]);
        *(GAS v4u*)(WT + (size_t)(n0 + n) * K + k0 + 8 * c) = o; }
    LDS_WAIT(); asm volatile("" ::: "memory");
}

__device__ __forceinline__ void ph_prologue(const Args& a, const Ctx& c) {
    unsigned char* ws = a.ws;
    LAS float* scr = (LAS float*)(c.lds + c.wave * 16384);
    const int gw = c.bx * NWAVES + c.wave, NGW = c.G * NWAVES;
    constexpr int I_IN = (D / 64) * (N_IN / 32), I_OUT = (D / 64) * (D / 32), I_UP = (D / 64) * (NUP / 32), I_DN = (DFF / 64) * (D / 32);
    constexpr int NITEMS = I_IN + I_OUT + I_UP + I_DN;
    for (int it = gw; it < NITEMS; it += NGW) {
        int r = it;
        if (r < I_IN) { p0_transpose_item(a.w_in, D, N_IN, (bf16*)(ws + WS_WIN), scr, r, c.lane); continue; } r -= I_IN;
        if (r < I_OUT) { p0_transpose_item(a.w_out, D, D, (bf16*)(ws + WS_WOUT), scr, r, c.lane); continue; } r -= I_OUT;
        if (r < I_UP) { p0_transpose_item(a.w_up, D, NUP, (bf16*)(ws + WS_WUP), scr, r, c.lane); continue; } r -= I_UP;
        p0_transpose_item(a.w_down, DFF, D, (bf16*)(ws + WS_WDN), scr, r, c.lane);
    }
    { GAS v4u* z = (GAS v4u*)(ws + WS_WIN + (size_t)N_IN * D * 2); const int n16 = (N_INP - N_IN) * D * 2 / 16;
      for (int i = c.bx * NTHR + c.tid; i < n16; i += c.G * NTHR) z[i] = (v4u){0u, 0u, 0u, 0u}; }
    { float* modp = (float*)(ws + WS_MODP);
      for (int it = c.bx; it < KSPLIT * (MODW / NTHR); it += c.G) {
          const int kb = it / (MODW / NTHR), jb = it % (MODW / NTHR), j = jb * NTHR + c.tid;
          float acc[5] = {0.f, 0.f, 0.f, 0.f, 0.f};
          for (int k = kb * 64; k < kb * 64 + 64; ++k) {
              const float w = a.ada_w[(size_t)k * MODW + j];
#pragma unroll
              for (int r = 0; r < 5; ++r) { const float cv = (r < 4) ? a.c[r * D + k] : a.c_ctx[k]; acc[r] += silu_f(cv) * w; }
          }
#pragma unroll
          for (int r = 0; r < 5; ++r) modp[((size_t)kb * 5 + r) * MODW + j] = acc[r];
      } }
}

__device__ __forceinline__ void ph_modreduce(const Args& a, const Ctx& c) {
    const float* modp = (const float*)(a.ws + WS_MODP); float* mod = (float*)(a.ws + WS_MOD);
    for (int i = c.bx * NTHR + c.tid; i < 5 * MODW; i += c.G * NTHR) {
        const int j = i % MODW; float s = a.ada_b[j];
        for (int kb = 0; kb < KSPLIT; ++kb) s += modp[(size_t)kb * 5 * MODW + i];
        mod[i] = s;
    }
}

__device__ __forceinline__ void ph_prenorm(const Args& a, const Ctx& c) {
    const float* mod = (const float*)(a.ws + WS_MOD); bf16* A1 = (bf16*)(a.ws + WS_RA);
    const int gw = c.bx * NWAVES + c.wave, NGW = c.G * NWAVES;
    for (int m = gw; m < M_ALL; m += NGW) {
        const float* xr; int mr;
        if (m < M_LAT) { xr = a.x + (size_t)m * D; mr = m / SEQ; } else { xr = a.ctx + (size_t)(m - M_LAT) * D; mr = 4; }
        const float* sh = mod + (size_t)mr * MODW; const float* sc = sh + D;
        f32x4 v[8]; float s = 0.f;
#pragma unroll
        for (int j = 0; j < 8; ++j) { v[j] = *(const f32x4*)(xr + 4 * c.lane + 256 * j); s += (v[j].x * v[j].x + v[j].y * v[j].y) + (v[j].z * v[j].z + v[j].w * v[j].w); }
        const float rstd = 1.0f / sqrtf(wave_sum(s) * (1.0f / D) + EPS);
#pragma unroll
        for (int j = 0; j < 8; ++j) { const int col = 4 * c.lane + 256 * j;
            const f32x4 g = *(const f32x4*)(a.pre_mix_g + col), s1 = *(const f32x4*)(sc + col), s0 = *(const f32x4*)(sh + col);
            const f32x4 o = v[j] * rstd * g * (1.0f + s1) + s0;
            v2u w; w.x = pk2(o.x, o.y); w.y = pk2(o.z, o.w); *(v2u*)(A1 + (size_t)m * D + col) = w; }
    }
}

__device__ __forceinline__ float logsigmoid_f(float z) { return fminf(z, 0.f) - log1pf(expf(-fabsf(z))); }

__device__ __forceinline__ void ph_gates_vp(const Args& a, const Ctx& c) {
    const bf16* P = (const bf16*)(a.ws + WS_P); float* Gt = (float*)(a.ws + WS_G); bf16* VP = (bf16*)(a.ws + WS_VP);
    for (int it = c.bx; it < 2 * M_ALL; it += c.G) {
        const int row = it >> 1, dir = it & 1; const float* W = dir ? a.gate_w_b : a.gate_w_f; const float* Bv = dir ? a.gate_b_b : a.gate_b_f;
        float z = Bv[c.tid];
#pragma unroll
        for (int j = 0; j < GLR; ++j) z += bf2f(P[(size_t)row * N_INP + C_LRF + dir * GLR + j]) * W[j * GKDIM + c.tid];
        Gt[((size_t)dir * M_ALL + row) * GKDIM + c.tid] = logsigmoid_f(z) * (1.0f / 16.0f);
    }
    const int gw = c.bx * NWAVES + c.wave, NGW = c.G * NWAVES;
    for (int it = gw; it < M_LAT * SGU_G; it += NGW) {
        const int row = it >> 2, g = it & 3; const int col = g * SGU_GW + 4 * c.lane;
        const v2u w = *(const v2u*)(P + (size_t)row * N_INP + C_VS + col);
        float v0 = gelu_t(bflo(w.x)), v1 = gelu_t(bfhi(w.x)), v2 = gelu_t(bflo(w.y)), v3 = gelu_t(bfhi(w.y));
        const float mu = wave_sum((v0 + v1) + (v2 + v3)) * (1.0f / SGU_GW);
        v0 -= mu; v1 -= mu; v2 -= mu; v3 -= mu;
        const float rstd = 1.0f / sqrtf(wave_sum((v0 * v0 + v1 * v1) + (v2 * v2 + v3 * v3)) * (1.0f / SGU_GW) + EPS);
        const f32x4 lg = *(const f32x4*)(a.sgu_ln_g + col), lb = *(const f32x4*)(a.sgu_ln_b + col);
        v2u o; o.x = pk2(v0 * rstd * lg.x + lb.x, v1 * rstd * lg.y + lb.y); o.y = pk2(v2 * rstd * lg.z + lb.z, v3 * rstd * lg.w + lb.w);
        *(v2u*)(VP + (size_t)row * MIXA + col) = o;
    }
}

__device__ __forceinline__ void ph_mix_naive(const Args& a, const Ctx& c) {
    const bf16* P = (const bf16*)(a.ws + WS_P); const float* Gt = (const float*)(a.ws + WS_G); const bf16* VP = (const bf16*)(a.ws + WS_VP);
    bf16* YC = (bf16*)(a.ws + WS_RA); float* O = a.out;
    for (int it = c.bx; it < M_LAT * 2; it += c.G) {
        const int row = it >> 1, g = 2 * (it & 1) + (c.tid >> 8), ch = g * SGU_GW + (c.tid & 255);
        const int b = row / SEQ, t = row % SEQ, n = t / SGU_P, p = t % SGU_P;
        const float* wr = a.sgu_w + ((size_t)g * SGU_P + p) * SGU_P; const bf16* vp = VP + ((size_t)b * SEQ + n * SGU_P) * MIXA + ch;
        float s = a.sgu_b[g * SGU_P + p];
        for (int q = 0; q < SGU_P; ++q) s += wr[q] * bf2f(vp[(size_t)q * MIXA]);
        const float u = gelu_t(bf2f(P[(size_t)row * N_INP + C_U + ch]));
        YC[(size_t)row * D + ch] = (bf16)f2bf(u * s);
    }
    if (c.bx < 16) {
        constexpr int TB = 16;
        const int half = c.tid >> 8, v = c.tid & 255, chain = c.bx * 2 + half, b = chain >> 3, h = (chain >> 1) & 3, dir = chain & 1;
        LAS float* st = (LAS float*)c.lds + half * (TB * 384);
        float S[GDK];
#pragma unroll
        for (int d = 0; d < GDK; ++d) S[d] = 0.f;
        for (int i0 = 0; i0 < CTX + SEQ; i0 += TB) {
            __syncthreads();
            for (int idx = v; idx < TB * 384; idx += 256) {
                const int tt = idx / 384, e = idx % 384, i = i0 + tt;
                const int row = (i < CTX) ? (M_LAT + b * CTX + (dir ? CTX - 1 - i : i)) : (b * SEQ + (dir ? SEQ - 1 - (i - CTX) : (i - CTX)));
                float val;
                if (e < 128) val = bf2f(P[(size_t)row * N_INP + C_Q + h * GDK + e]) * 0.08838834764831845f;
                else if (e < 256) val = bf2f(P[(size_t)row * N_INP + C_K + h * GDK + (e - 128)]);
                else val = expf(Gt[((size_t)dir * M_ALL + row) * GKDIM + h * GDK + (e - 256)]);
                st[idx] = val;
            }
            __syncthreads();
            for (int tt = 0; tt < TB; ++tt) {
                const int i = i0 + tt;
                const int row = (i < CTX) ? (M_LAT + b * CTX + (dir ? CTX - 1 - i : i)) : (b * SEQ + (dir ? SEQ - 1 - (i - CTX) : (i - CTX)));
                const float vv = bf2f(P[(size_t)row * N_INP + C_V + h * GDV + v]);
                const LAS float* q = st + tt * 384; float o = 0.f;
#pragma unroll
                for (int d = 0; d < GDK; ++d) { S[d] = q[256 + d] * S[d] + q[128 + d] * vv; o += q[d] * S[d]; }
                if (i >= CTX) O[((size_t)dir * M_LAT + row) * MIXB + h * GDV + v] = o;
            }
        }
    }
}


typedef short bf16x8 __attribute__((ext_vector_type(8)));
typedef short s16x4 __attribute__((ext_vector_type(4)));
typedef LAS const unsigned char* ldsp;
__device__ __forceinline__ bf16x8 lds_row8(ldsp p) { return *(const LAS bf16x8*)p; }
__device__ __forceinline__ bf16x8 lds_tr8(ldsp p, int pitch) {
    const s16x4 lo = __builtin_bit_cast(s16x4, __builtin_amdgcn_ds_read_tr16_b64_v4i16((LAS s16x4*)p));
    const s16x4 hi = __builtin_bit_cast(s16x4, __builtin_amdgcn_ds_read_tr16_b64_v4i16((LAS s16x4*)(p + 4 * pitch)));
    return __builtin_shufflevector(lo, hi, 0, 1, 2, 3, 4, 5, 6, 7);
}
#define MFMA16(a, b, c) __builtin_amdgcn_mfma_f32_16x16x32_bf16((a), (b), (c), 0, 0, 0)
constexpr int NCK = CTX / 64 + SEQ / 64;
constexpr size_t WS_QE = WS_G, WS_KE = WS_G + 34 * MiB;
constexpr size_t WS_DEC = WS_VP;
__device__ __forceinline__ float logsig_fast(float z) { return fminf(z, 0.f) - __logf(1.0f + __expf(-fabsf(z))); }

__device__ __forceinline__ void prep_item(const Args& a, const Ctx& c, int item) {
    const bf16* P = (const bf16*)(a.ws + WS_P);
    const int h = item & 3, ck = (item >> 2) % NCK, b = (item >> 2) / NCK;
    const int r0 = ck < 4 ? (M_LAT + b * CTX + 64 * ck) : (b * SEQ + 64 * (ck - 4));
    LAS float* lrs = (LAS float*)c.lds;
    LAS float* tot = lrs + 64 * 32;
    const int dir = c.tid >> 8, half = (c.tid >> 7) & 1, d = c.tid & 127;
    { const int row = c.tid >> 3, c4 = (c.tid & 7) * 4; const v2u w = *(const v2u*)(P + (size_t)(r0 + row) * N_INP + C_LRF + c4);
      *(LAS f32x4*)(lrs + row * 32 + c4) = (f32x4){bflo(w.x), bfhi(w.x), bflo(w.y), bfhi(w.y)}; }
    const float* W = dir ? a.gate_w_b : a.gate_w_f; const float bias = (dir ? a.gate_b_b : a.gate_b_f)[h * GDK + d];
    float w[GLR];
#pragma unroll
    for (int j = 0; j < GLR; ++j) w[j] = W[j * GKDIM + h * GDK + d];
    __syncthreads();
    float g[32];
#pragma unroll
    for (int tt = 0; tt < 32; ++tt) { const LAS float* lr = lrs + (half * 32 + tt) * 32 + dir * GLR; float z = bias;
#pragma unroll
        for (int j = 0; j < GLR; ++j) z += lr[j] * w[j];
        g[tt] = logsig_fast(z) * (1.0f / 16.0f); }
    float run = 0.f;
    if (dir == 0) {
#pragma unroll
        for (int tt = 0; tt < 32; ++tt) { run += g[tt]; g[tt] = run; }
    } else {
#pragma unroll
        for (int tt = 31; tt >= 0; --tt) { run += g[tt]; g[tt] = run; }
    }
    tot[(dir * 2 + half) * 128 + d] = run;
    __syncthreads();
    const float other = tot[(dir * 2 + (half ^ 1)) * 128 + d];
    const float add = (dir == 0) ? (half == 1 ? other : 0.f) : (half == 0 ? other : 0.f);
    if (half == 0) ((float*)(a.ws + WS_DEC))[((size_t)(dir * BATCH + b) * NCK + ck) * GKDIM + h * GDK + d] = __expf(run + other);
    bf16* QE = (bf16*)(a.ws + WS_QE) + (size_t)dir * M_ALL * GKDIM; bf16* KE = (bf16*)(a.ws + WS_KE) + (size_t)dir * M_ALL * GKDIM;
#pragma unroll
    for (int tt = 0; tt < 32; ++tt) { const int row = r0 + half * 32 + tt; const float bb = g[tt] + add;
        const float q = bf2f(P[(size_t)row * N_INP + C_Q + h * GDK + d]), k = bf2f(P[(size_t)row * N_INP + C_K + h * GDK + d]);
        QE[(size_t)row * GKDIM + h * GDK + d] = (bf16)f2bf(q * 0.08838834764831845f * __expf(bb));
        KE[(size_t)row * GKDIM + h * GDK + d] = (bf16)f2bf(k * __expf(-bb)); }
}

__device__ __forceinline__ void sgu_item(const Args& a, const Ctx& c, int item) {
    constexpr int WP = 272, VPP = 528;
    const bf16* P = (const bf16*)(a.ws + WS_P); bf16* YC = (bf16*)(a.ws + WS_RA);
    const int g = item & 3, n = (item >> 2) & 31, b = item >> 7, r0 = b * SEQ + n * SGU_P;
    LAS unsigned char* Wb = c.lds; LAS unsigned char* Vt = c.lds + 128 * WP;
    const float* Ws = a.sgu_w + (size_t)g * SGU_P * SGU_P;
#pragma unroll
    for (int i = 0; i < 8; ++i) { const int idx = c.tid + 512 * i, p = idx >> 5, c4 = (idx & 31) * 4; const f32x4 w = *(const f32x4*)(Ws + p * SGU_P + c4);
        v2u o; o.x = pk2(w.x, w.y); o.y = pk2(w.z, w.w); *(LAS v2u*)(Wb + p * WP + c4 * 2) = o; }
    const int col = g * SGU_GW + 4 * c.lane;
    const f32x4 lg = *(const f32x4*)(a.sgu_ln_g + col), lb = *(const f32x4*)(a.sgu_ln_b + col);
    for (int i = 0; i < 16; ++i) { const int q = c.wave * 16 + i;
        const v2u w = *(const v2u*)(P + (size_t)(r0 + q) * N_INP + C_VS + col);
        float v0 = gelu_t(bflo(w.x)), v1 = gelu_t(bfhi(w.x)), v2 = gelu_t(bflo(w.y)), v3 = gelu_t(bfhi(w.y));
        const float mu = wave_sum((v0 + v1) + (v2 + v3)) * (1.0f / SGU_GW);
        v0 -= mu; v1 -= mu; v2 -= mu; v3 -= mu;
        const float rstd = 1.0f / sqrtf(wave_sum((v0 * v0 + v1 * v1) + (v2 * v2 + v3 * v3)) * (1.0f / SGU_GW) + EPS);
        v2u o; o.x = pk2(v0 * rstd * lg.x + lb.x, v1 * rstd * lg.y + lb.y); o.y = pk2(v2 * rstd * lg.z + lb.z, v3 * rstd * lg.w + lb.w);
        *(LAS v2u*)(Vt + q * VPP + 8 * c.lane) = o; }
    __syncthreads();
    const int l15 = c.lane & 15, lg4 = c.lane >> 4, tq = l15 >> 2, tp = l15 & 3;
    bf16x8 wf[4];
#pragma unroll
    for (int kc = 0; kc < 4; ++kc) wf[kc] = lds_row8(Wb + (16 * c.wave + l15) * WP + (32 * kc + 8 * lg4) * 2);
    const int p = 16 * c.wave + l15, row = r0 + p; const float bs = a.sgu_b[g * SGU_P + p];
    for (int cj = 0; cj < 16; ++cj) {
        f32x4 acc = {0.f, 0.f, 0.f, 0.f};
#pragma unroll
        for (int kc = 0; kc < 4; ++kc) { const bf16x8 vf = lds_tr8(Vt + (32 * kc + 8 * lg4 + tq) * VPP + (16 * cj + 4 * tp) * 2, VPP); acc = MFMA16(vf, wf[kc], acc); }
        const int ch = g * SGU_GW + 16 * cj + 4 * lg4;
        const v2u uw = *(const v2u*)(P + (size_t)row * N_INP + C_U + ch);
        v2u o; o.x = pk2(gelu_t(bflo(uw.x)) * (acc[0] + bs), gelu_t(bfhi(uw.x)) * (acc[1] + bs)); o.y = pk2(gelu_t(bflo(uw.y)) * (acc[2] + bs), gelu_t(bfhi(uw.y)) * (acc[3] + bs));
        *(v2u*)(YC + (size_t)row * D + ch) = o;
    }
    __syncthreads();
}

__device__ __forceinline__ void ph_prep(const Args& a, const Ctx& c) {
    for (int it = c.bx; it < BATCH * NCK * GH; it += c.G) prep_item(a, c, it);
    __syncthreads();
    for (int it = c.bx; it < BATCH * 32 * SGU_G; it += c.G) sgu_item(a, c, it);
}

__device__ __forceinline__ void ph_chains(const Args& a, const Ctx& c) {
    constexpr int QP = 272, VP = 80, AP = 144, SP = 272;
    constexpr int OFF_Q = 0, OFF_K = 64 * QP, OFF_V = 2 * 64 * QP, BUF = 2 * 64 * QP + 64 * VP;
    constexpr int OFF_ATT = 2 * BUF, OFF_ST = OFF_ATT + 64 * AP, ST_BYTES = 32 * SP;
    const bf16* P = (const bf16*)(a.ws + WS_P); float* O = a.out;
    const int l15 = c.lane & 15, lg4 = c.lane >> 4, tq = l15 >> 2, tp = l15 & 3, w = c.wave;
    for (int unit = ((c.G % 8 == 0) ? (c.bx % 8) * (c.G / 8) + c.bx / 8 : c.bx); unit < 256; unit += c.G) {
        const int dvs = unit & 7, chain = unit >> 3, b = chain >> 3, h = (chain >> 1) & 3, dir = chain & 1;
        const bf16* QEg = (const bf16*)(a.ws + WS_QE) + (size_t)dir * M_ALL * GKDIM + h * GDK;
        const bf16* KEg = (const bf16*)(a.ws + WS_KE) + (size_t)dir * M_ALL * GKDIM + h * GDK;
        const bf16* Vg = P + C_V + h * GDV + dvs * 32;
        const float* DECg = (const float*)(a.ws + WS_DEC) + (size_t)(dir * BATCH + b) * NCK * GKDIM + h * GDK + 16 * w + 4 * lg4;
        float* Og = O + (size_t)dir * M_LAT * MIXB + h * GDV + dvs * 32;
        auto chunk_of = [&](int i) { return i < 4 ? (dir ? 3 - i : i) : 4 + (dir ? 63 - (i - 4) : (i - 4)); };
        auto row0_of = [&](int ck) { return ck < 4 ? (M_LAT + b * CTX + 64 * ck) : (b * SEQ + 64 * (ck - 4)); };
        v4u rq[2], rk[2], rv;
        auto gload = [&](int ck) { const int r0 = row0_of(ck);
#pragma unroll
            for (int i = 0; i < 2; ++i) { const int idx = c.tid + 512 * i, r = idx >> 4, ch = idx & 15;
                rq[i] = *(const v4u*)(QEg + (size_t)(r0 + r) * GKDIM + ch * 8); rk[i] = *(const v4u*)(KEg + (size_t)(r0 + r) * GKDIM + ch * 8); }
            if (c.tid < 256) rv = *(const v4u*)(Vg + (size_t)(r0 + (c.tid >> 2)) * N_INP + (c.tid & 3) * 8); };
        auto lstore = [&](int buf) { LAS unsigned char* B = c.lds + buf * BUF;
#pragma unroll
            for (int i = 0; i < 2; ++i) { const int idx = c.tid + 512 * i, r = idx >> 4, ch = idx & 15;
                *(LAS v4u*)(B + OFF_Q + r * QP + ch * 16) = rq[i]; *(LAS v4u*)(B + OFF_K + r * QP + ch * 16) = rk[i]; }
            if (c.tid < 256) *(LAS v4u*)(B + OFF_V + (c.tid >> 2) * VP + (c.tid & 3) * 16) = rv; };
        __syncthreads();
        gload(chunk_of(0)); lstore(0);
        for (int i = c.tid; i < 2 * ST_BYTES / 4; i += NTHR) ((LAS unsigned*)(c.lds + OFF_ST))[i] = 0u;
        f32x4 Sacc[2] = {{0.f, 0.f, 0.f, 0.f}, {0.f, 0.f, 0.f, 0.f}};
        __syncthreads();
        for (int i = 0; i < NCK; ++i) {
            const int ck = chunk_of(i), cur = i & 1; ldsp B = c.lds + cur * BUF; LAS unsigned char* ATT = c.lds + OFF_ATT;
            ldsp STc = c.lds + OFF_ST + cur * ST_BYTES; LAS unsigned char* STn = c.lds + OFF_ST + (cur ^ 1) * ST_BYTES;
            if (i + 1 < NCK) gload(chunk_of(i + 1));
            const f32x4 dec = *(const f32x4*)(DECg + (size_t)ck * GKDIM);
            if (ck >= 4) {
                const int ti = w >> 1;
                bf16x8 qf[4];
#pragma unroll
                for (int kc = 0; kc < 4; ++kc) qf[kc] = lds_row8(B + OFF_Q + (16 * ti + l15) * QP + (32 * kc + 8 * lg4) * 2);
#pragma unroll
                for (int jj = 0; jj < 2; ++jj) { const int sj = 2 * (w & 1) + jj; f32x4 acc = {0.f, 0.f, 0.f, 0.f};
#pragma unroll
                    for (int kc = 0; kc < 4; ++kc) acc = MFMA16(lds_row8(B + OFF_K + (16 * sj + l15) * QP + (32 * kc + 8 * lg4) * 2), qf[kc], acc);
                    const int t = 16 * ti + l15, s0 = 16 * sj + 4 * lg4;
#pragma unroll
                    for (int r = 0; r < 4; ++r) { const bool keep = dir ? (s0 + r >= t) : (s0 + r <= t); if (!keep) acc[r] = 0.f; }
                    v2u o; o.x = pk2(acc[0], acc[1]); o.y = pk2(acc[2], acc[3]); *(LAS v2u*)(ATT + t * AP + s0 * 2) = o; }
                __syncthreads();
                const int vj = w & 1; f32x4 oacc = {0.f, 0.f, 0.f, 0.f};
#pragma unroll
                for (int kc = 0; kc < 2; ++kc) oacc = MFMA16(lds_tr8(B + OFF_V + (32 * kc + 8 * lg4 + tq) * VP + (16 * vj + 4 * tp) * 2, VP), lds_row8(ATT + (16 * ti + l15) * AP + (32 * kc + 8 * lg4) * 2), oacc);
#pragma unroll
                for (int kc = 0; kc < 4; ++kc) oacc = MFMA16(lds_row8(STc + (16 * vj + l15) * SP + (32 * kc + 8 * lg4) * 2), qf[kc], oacc);
                *(f32x4*)(Og + (size_t)(row0_of(ck) + 16 * ti + l15) * MIXB + 16 * vj + 4 * lg4) = oacc;
            }
#pragma unroll
            for (int kc = 0; kc < 2; ++kc) { const bf16x8 kf = lds_tr8(B + OFF_K + (32 * kc + 8 * lg4 + tq) * QP + (16 * w + 4 * tp) * 2, QP);
#pragma unroll
                for (int vj = 0; vj < 2; ++vj) Sacc[vj] = MFMA16(kf, lds_tr8(B + OFF_V + (32 * kc + 8 * lg4 + tq) * VP + (16 * vj + 4 * tp) * 2, VP), Sacc[vj]); }
#pragma unroll
            for (int vj = 0; vj < 2; ++vj) { Sacc[vj] = Sacc[vj] * dec;
                v2u o; o.x = pk2(Sacc[vj][0], Sacc[vj][1]); o.y = pk2(Sacc[vj][2], Sacc[vj][3]); *(LAS v2u*)(STn + (16 * vj + l15) * SP + (16 * w + 4 * lg4) * 2) = o; }
            if (i + 1 < NCK) lstore(cur ^ 1);
            __syncthreads();
        }
    }
}

__device__ __forceinline__ void ph_combine(const Args& a, const Ctx& c) {
    const bf16* P = (const bf16*)(a.ws + WS_P); bf16* YC = (bf16*)(a.ws + WS_RA); const float* O = a.out;
    const int gw = c.bx * NWAVES + c.wave, NGW = c.G * NWAVES;
    for (int it = gw; it < M_LAT * GH; it += NGW) {
        const int row = it >> 2, h = it & 3, col = h * GDV + 4 * c.lane;
        const f32x4 of = *(const f32x4*)(O + (size_t)row * MIXB + col), ob = *(const f32x4*)(O + ((size_t)M_LAT + row) * MIXB + col);
        const f32x4 o = of + ob;
        const float rstd = 1.0f / sqrtf(wave_sum((o.x * o.x + o.y * o.y) + (o.z * o.z + o.w * o.w)) * (1.0f / GDV) + EPS);
        const f32x4 ng = *(const f32x4*)(a.gla_norm_g + 4 * c.lane);
        const v2u rw = *(const v2u*)(P + (size_t)row * N_INP + C_R + col);
        v2u w; w.x = pk2(o.x * rstd * ng.x * silu_f(bflo(rw.x)), o.y * rstd * ng.y * silu_f(bfhi(rw.x)));
        w.y = pk2(o.z * rstd * ng.z * silu_f(bflo(rw.y)), o.w * rstd * ng.w * silu_f(bfhi(rw.y)));
        *(v2u*)(YC + (size_t)row * D + MIXA + col) = w;
    }
}

__device__ __forceinline__ void ph_mid(const Args& a, const Ctx& c) {
    const float* mod = (const float*)(a.ws + WS_MOD); const bf16* Y = (const bf16*)(a.ws + WS_P); bf16* Fo = (bf16*)(a.ws + WS_RA);
    const int gw = c.bx * NWAVES + c.wave, NGW = c.G * NWAVES;
    for (int m = gw; m < M_LAT; m += NGW) {
        const float* mr = mod + (size_t)(m / SEQ) * MODW; const float *gtm = mr + 2 * D, *shf = mr + 3 * D, *scf = mr + 4 * D;
        f32x4 y[8]; float s = 0.f;
#pragma unroll
        for (int j = 0; j < 8; ++j) { const v2u w = *(const v2u*)(Y + (size_t)m * D + 4 * c.lane + 256 * j); y[j] = (f32x4){bflo(w.x), bfhi(w.x), bflo(w.y), bfhi(w.y)};
            s += (y[j].x * y[j].x + y[j].y * y[j].y) + (y[j].z * y[j].z + y[j].w * y[j].w); }
        const float rstd = 1.0f / sqrtf(wave_sum(s) * (1.0f / D) + EPS); float s2 = 0.f;
#pragma unroll
        for (int j = 0; j < 8; ++j) { const int col = 4 * c.lane + 256 * j;
            const f32x4 xv = *(const f32x4*)(a.x + (size_t)m * D + col), g = *(const f32x4*)(a.post_mix_g + col), gt = *(const f32x4*)(gtm + col);
            y[j] = xv + gt * (y[j] * rstd * g); *(f32x4*)(a.out + (size_t)m * D + col) = y[j];
            s2 += (y[j].x * y[j].x + y[j].y * y[j].y) + (y[j].z * y[j].z + y[j].w * y[j].w); }
        const float rstd2 = 1.0f / sqrtf(wave_sum(s2) * (1.0f / D) + EPS);
#pragma unroll
        for (int j = 0; j < 8; ++j) { const int col = 4 * c.lane + 256 * j;
            const f32x4 g = *(const f32x4*)(a.pre_ffn_g + col), s1 = *(const f32x4*)(scf + col), s0 = *(const f32x4*)(shf + col);
            const f32x4 o = y[j] * rstd2 * g * (1.0f + s1) + s0;
            v2u w; w.x = pk2(o.x, o.y); w.y = pk2(o.z, o.w); *(v2u*)(Fo + (size_t)m * D + col) = w; }
    }
}

__device__ __forceinline__ void ph_conv(const Args& a, const Ctx& c) {
    bf16* U = (bf16*)(a.ws + WS_RU);
    constexpr int CH = DFF / 8;
    for (long idx = (long)c.bx * NTHR + c.tid; idx < (long)M_LAT * CH; idx += (long)c.G * NTHR) {
        const int m = (int)(idx / CH), ch = (int)(idx % CH) * 8, b = m / SEQ, t = m % SEQ, gi = t / GRIDW, gj = t % GRIDW;
        float acc[8];
        { const f32x4 b0 = *(const f32x4*)(a.conv_b + ch), b1 = *(const f32x4*)(a.conv_b + ch + 4);
          acc[0] = b0.x; acc[1] = b0.y; acc[2] = b0.z; acc[3] = b0.w; acc[4] = b1.x; acc[5] = b1.y; acc[6] = b1.z; acc[7] = b1.w; }
#pragma unroll
        for (int di = 0; di < 3; ++di)
#pragma unroll
            for (int dj = 0; dj < 3; ++dj) {
                const int ii = gi + di - 1, jj = gj + dj - 1;
                if (ii < 0 || ii >= GRIDW || jj < 0 || jj >= GRIDW) continue;
                const v4u w = *(const v4u*)(U + ((size_t)b * SEQ + ii * GRIDW + jj) * NUP + ch);
                const f32x4 k0 = *(const f32x4*)(a.conv_w + (size_t)(di * 3 + dj) * DFF + ch), k1 = *(const f32x4*)(a.conv_w + (size_t)(di * 3 + dj) * DFF + ch + 4);
                acc[0] += bflo(w.x) * k0.x; acc[1] += bfhi(w.x) * k0.y; acc[2] += bflo(w.y) * k0.z; acc[3] += bfhi(w.y) * k0.w;
                acc[4] += bflo(w.z) * k1.x; acc[5] += bfhi(w.z) * k1.y; acc[6] += bflo(w.w) * k1.z; acc[7] += bfhi(w.w) * k1.w;
            }
        const v4u vw = *(const v4u*)(U + (size_t)m * NUP + DFF + ch);
        v4u o; o.x = pk2(gelu_t(acc[0]) * bflo(vw.x), gelu_t(acc[1]) * bfhi(vw.x)); o.y = pk2(gelu_t(acc[2]) * bflo(vw.y), gelu_t(acc[3]) * bfhi(vw.y));
        o.z = pk2(gelu_t(acc[4]) * bflo(vw.z), gelu_t(acc[5]) * bfhi(vw.z)); o.w = pk2(gelu_t(acc[6]) * bflo(vw.w), gelu_t(acc[7]) * bfhi(vw.w));
        *(v4u*)(U + (size_t)m * NUP + DFF + ch) = o;
    }
}

__device__ __forceinline__ void ph_final(const Args& a, const Ctx& c) {
    const float* mod = (const float*)(a.ws + WS_MOD); const bf16* Z = (const bf16*)(a.ws + WS_RA);
    const int gw = c.bx * NWAVES + c.wave, NGW = c.G * NWAVES;
    for (int m = gw; m < M_LAT; m += NGW) {
        const float* gtf = mod + (size_t)(m / SEQ) * MODW + 5 * D;
        f32x4 z[8]; float s = 0.f;
#pragma unroll
        for (int j = 0; j < 8; ++j) { const v2u w = *(const v2u*)(Z + (size_t)m * D + 4 * c.lane + 256 * j); z[j] = (f32x4){bflo(w.x), bfhi(w.x), bflo(w.y), bfhi(w.y)};
            s += (z[j].x * z[j].x + z[j].y * z[j].y) + (z[j].z * z[j].z + z[j].w * z[j].w); }
        const float rstd = 1.0f / sqrtf(wave_sum(s) * (1.0f / D) + EPS);
#pragma unroll
        for (int j = 0; j < 8; ++j) { const int col = 4 * c.lane + 256 * j;
            const f32x4 hv = *(const f32x4*)(a.out + (size_t)m * D + col), g = *(const f32x4*)(a.post_ffn_g + col), gt = *(const f32x4*)(gtf + col);
            *(f32x4*)(a.out + (size_t)m * D + col) = hv + gt * (z[j] * rstd * g); }
    }
}

#define XB_TMO      128
#define XB_XCNT(j)  (256  + 64 * (j))
#define XB_XSUB(j)  (1280 + 64 * (j))
#define XB_XGEN(j)  (2304 + 64 * (j))
#define XB_TOP      3328
#define XB_TOPGEN   3392
#define XCD_BAR_WORDS 3456
#define XB_SPIN_CAP (1u << 18)

__device__ __forceinline__ unsigned xb_ld(unsigned* p)              { return __hip_atomic_load(p, __ATOMIC_RELAXED, __HIP_MEMORY_SCOPE_AGENT); }
__device__ __forceinline__ unsigned xb_add(unsigned* p, unsigned v) { return __hip_atomic_fetch_add(p, v, __ATOMIC_RELAXED, __HIP_MEMORY_SCOPE_AGENT); }
__device__ __forceinline__ unsigned xb_xcc_id() { return (unsigned)__builtin_amdgcn_s_getreg((3 << 11) | 20) & 0xFu; }
#define XB_SPIN(cond, bar) do { unsigned _sp = 0; while (cond) { __builtin_amdgcn_s_sleep(1); \
    if ((++_sp & 255u) == 0u) { if (xb_ld(&(bar)[XB_TMO])) break; if (_sp > XB_SPIN_CAP) { atomicAdd(&(bar)[XB_TMO], 1u); break; } } } } while (0)

struct XcdBarrier {
    unsigned* bar; unsigned x;
    volatile LAS unsigned* st;
};

__device__ __forceinline__ XcdBarrier xcd_barrier_post(unsigned* bar, volatile LAS unsigned* st) {
    XcdBarrier b; b.bar = bar; b.x = xb_xcc_id(); b.st = st;
    if (threadIdx.x == 0) (void)xb_add(&bar[XB_XCNT(b.x)], 1u);
    return b;
}
__device__ __forceinline__ void xcd_barrier_complete(unsigned* bar, unsigned x, unsigned& nloc, unsigned& nx) {
    const unsigned G = gridDim.x * gridDim.y * gridDim.z;
    unsigned sum, cnt, mine, sp = 0u;
    for (;;) {
        sum = 0u; cnt = 0u; mine = 0u;
#pragma unroll
        for (unsigned j = 0; j < 16; ++j) { const unsigned c = xb_ld(&bar[XB_XCNT(j)]); sum += c; cnt += (c > 0u) ? 1u : 0u; mine = (j == x) ? c : mine; }
        if (sum == G) break;
        __builtin_amdgcn_s_sleep(1);
        if ((++sp & 255u) == 0u) { if (xb_ld(&bar[XB_TMO])) break; if (sp > XB_SPIN_CAP) { atomicAdd(&bar[XB_TMO], 1u); break; } }
    }
    nloc = mine > 0u ? mine : 1u; nx = cnt > 0u ? cnt : 1u;
}

__device__ __forceinline__ void xcd_barrier(const XcdBarrier& b) {
    asm volatile("s_waitcnt vmcnt(0)" ::: "memory");
    __syncthreads();
    if (threadIdx.x == 0) {
        unsigned* bar = b.bar;
        __builtin_amdgcn_s_waitcnt(0);
        unsigned nloc = b.st[0], nx = b.st[1];
        if (nloc == 0u) { xcd_barrier_complete(bar, b.x, nloc, nx); b.st[0] = nloc; b.st[1] = nx; }
        const unsigned old = xb_add(&bar[XB_XSUB(b.x)], 1u);
        const unsigned gen = old / nloc;
        if (old + 1u == (gen + 1u) * nloc) {
            __builtin_amdgcn_fence(__ATOMIC_RELEASE, "agent");
            asm volatile("s_waitcnt vmcnt(0)" ::: "memory");
            const unsigned og = xb_add(&bar[XB_TOP], 1u);
            const unsigned tg = og / nx;
            if (og + 1u == (tg + 1u) * nx) xb_add(&bar[XB_TOPGEN], 1u);
            else XB_SPIN(xb_ld(&bar[XB_TOPGEN]) == tg, bar);
            __builtin_amdgcn_fence(__ATOMIC_ACQUIRE, "agent");
            xb_add(&bar[XB_XGEN(b.x)], 1u);
            asm volatile("s_waitcnt vmcnt(0)" ::: "memory");
        } else {
            XB_SPIN(xb_ld(&bar[XB_XGEN(b.x)]) == gen, bar);
            __builtin_amdgcn_fence(__ATOMIC_ACQUIRE, "agent");
            asm volatile("s_waitcnt vmcnt(0)" ::: "memory");
        }
    }
    __syncthreads();
}

constexpr int N_PHASES = 13;
__global__ void __launch_bounds__(NTHR, 2) mk_fwd(Args a) {
    extern __shared__ __attribute__((aligned(16))) unsigned char lds_raw[];
    Ctx c; c.lds = (LAS unsigned char*)lds_raw; c.tid = threadIdx.x; c.lane = c.tid & 63; c.wave = __builtin_amdgcn_readfirstlane(c.tid >> 6); c.G = gridDim.x; c.bx = blockIdx.x;
    const int lo = a.ph_lo, hi = a.ph_hi;
    volatile LAS unsigned* MISC = (volatile LAS unsigned*)(c.lds + MISC_OFF);
    if (c.tid < 32) MISC[c.tid] = 0u;
    __syncthreads();
    XcdBarrier bar = xcd_barrier_post((unsigned*)(a.ws + WS_CTL) + 4096, MISC + 8);
    if (hi > 1000) cg::this_grid().sync();
#define IN(k) (lo <= (k) && (k) < hi)
#define SEAM(k) do { if (IN(k) && IN((k) + 1)) { xcd_barrier(bar); } } while (0)
    typedef pg8::EpiBf16<0> EpiB;
    if (IN(0)) { ph_prologue(a, c); } SEAM(0);
    if (IN(1)) { ph_modreduce(a, c); } SEAM(1);
    if (IN(2)) { ph_prenorm(a, c); } SEAM(2);
    if (IN(3)) {
        pg8::Gemm g{(const bf16*)(a.ws + WS_RA), (const bf16*)(a.ws + WS_WIN), M_ALL, N_INP, D, D}; pg8::StaticOrder S; S.init(M_ALL, N_INP, c.G, c.bx);
        EpiB E{(bf16*)(a.ws + WS_P), N_INP, nullptr, 0, 0, 1.f};
        pg8::gemm_phase<EpiB, pg8::StaticOrder, PG8_ALIGN, PG8_SP2>(c.lds, g, S, E);
    } SEAM(3);
#ifdef MIX_NAIVE
    if (IN(4)) { ph_gates_vp(a, c); } SEAM(4);
    if (IN(5)) { ph_mix_naive(a, c); } SEAM(5);
#else
    if (IN(4)) { ph_prep(a, c); } SEAM(4);
    if (IN(5)) { ph_chains(a, c); } SEAM(5);
#endif
    if (IN(6)) { ph_combine(a, c); } SEAM(6);
    if (IN(7)) {
        pg8::Gemm g{(const bf16*)(a.ws + WS_RA), (const bf16*)(a.ws + WS_WOUT), M_LAT, D, D, D}; pg8::StaticOrder S; S.init(M_LAT, D, c.G, c.bx);
        EpiB E{(bf16*)(a.ws + WS_P), D, nullptr, 0, 0, 1.f};
        pg8::gemm_phase<EpiB, pg8::StaticOrder, PG8_ALIGN, PG8_SP2>(c.lds, g, S, E);
    } SEAM(7);
    if (IN(8)) { ph_mid(a, c); } SEAM(8);
    if (IN(9)) {
        pg8::Gemm g{(const bf16*)(a.ws + WS_RA), (const bf16*)(a.ws + WS_WUP), M_LAT, NUP, D, D}; pg8::StaticOrder S; S.init(M_LAT, NUP, c.G, c.bx);
        EpiB E{(bf16*)(a.ws + WS_RU), NUP, nullptr, 0, 0, 1.f};
        pg8::gemm_phase<EpiB, pg8::StaticOrder, PG8_ALIGN, PG8_SP2>(c.lds, g, S, E);
    } SEAM(9);
    if (IN(10)) { ph_conv(a, c); } SEAM(10);
    if (IN(11)) {
        pg8::Gemm g{(const bf16*)(a.ws + WS_RU) + DFF, (const bf16*)(a.ws + WS_WDN), M_LAT, D, DFF, NUP}; pg8::StaticOrder S; S.init(M_LAT, D, c.G, c.bx);
        EpiB E{(bf16*)(a.ws + WS_RA), D, nullptr, 0, 0, 1.f};
        pg8::gemm_phase<EpiB, pg8::StaticOrder, PG8_ALIGN, PG8_SP2>(c.lds, g, S, E);
    } SEAM(11);
    if (IN(12)) { ph_final(a, c); }
#undef IN
#undef SEAM
}

#ifndef MK_ONE_LAUNCH
#define MK_ONE_LAUNCH 1
#endif
extern "C" void kernel_launch(void* const* d_in, const int* in_sizes, int n_in, void* d_out, int out_size, void* d_ws, size_t ws_size, hipStream_t stream) {
    static int grid = 0;
    if (grid == 0) {
        if (n_in != 25 || in_sizes[0] != M_LAT * D || out_size != M_LAT * D || ws_size < WS_END) { fprintf(stderr, "kernel_launch: unexpected shapes (n_in %d, ws %zu)\n", n_in, ws_size); grid = -1; return; }
        int dev = 0, cus = 0, per_cu = 0;
        (void)hipGetDevice(&dev); (void)hipDeviceGetAttribute(&cus, hipDeviceAttributeMultiprocessorCount, dev);
        (void)hipFuncSetAttribute((const void*)mk_fwd, hipFuncAttributeMaxDynamicSharedMemorySize, LDS_BYTES);
        (void)hipOccupancyMaxActiveBlocksPerMultiprocessor(&per_cu, (const void*)mk_fwd, NTHR, LDS_BYTES);
        (void)hipGetLastError();
        if (per_cu < 1) { fprintf(stderr, "kernel_launch: occupancy query says %d blocks per CU\n", per_cu); grid = -1; return; }
        grid = cus;
    }
    if (grid < 0) return;
    Args a{};
    const float** f = (const float**)&a;
    for (int i = 0; i < 25; ++i) f[i] = (const float*)d_in[i];
    a.out = (float*)d_out; a.ws = (unsigned char*)d_ws;
    (void)hipMemsetAsync((char*)d_ws + WS_CTL, 0, CTL_ZERO_BYTES, stream);
#if MK_ONE_LAUNCH
    a.ph_lo = 0; a.ph_hi = N_PHASES;
    void* args[] = {&a};
    hipError_t e = hipLaunchCooperativeKernel((const void*)mk_fwd, dim3(grid), dim3(NTHR), args, LDS_BYTES, stream);
    if (e != hipSuccess) fprintf(stderr, "cooperative launch failed: %s (grid %d)\n", hipGetErrorString(e), grid);
#else
    for (int p = 0; p < N_PHASES; ++p) { a.ph_lo = p; a.ph_hi = p + 1; hipLaunchKernelGGL(mk_fwd, dim3(grid), dim3(NTHR), LDS_BYTES, stream, a); }
#endif
}
```
